# Optimizing an MI355X kernel written in HIP

```python
import math
import jax
import jax.numpy as jnp
from jax import lax
import numpy as np

D_MODEL = 2048
BATCH = 8
SEQ = 4096
DEPTH = 4

HEAD_DIM = 128
MIX_WIDTH = D_MODEL
N_HEADS_TOTAL = MIX_WIDTH // HEAD_DIM
N_HEADS_SB = N_HEADS_TOTAL // 2
N_HEADS_DIL = N_HEADS_TOTAL - N_HEADS_SB
SB_WIDTH = N_HEADS_SB * HEAD_DIM
DIL_WIDTH = N_HEADS_DIL * HEAD_DIM
IN_WIDTH = 3 * (SB_WIDTH + DIL_WIDTH)
IN_SPLITS = (SB_WIDTH, 2 * SB_WIDTH, 3 * SB_WIDTH, 3 * SB_WIDTH + DIL_WIDTH, 3 * SB_WIDTH + 2 * DIL_WIDTH)
D_FF = -(-8 * D_MODEL // (3 * 256)) * 256
PLI_DIM = 256
BLOCK = 128
DIL_GROUPS = ((128, 1), (512, 4), (2048, 16))
NUM_BUCKETS = 32
MAX_DISTANCE = 2048
RMS_EPS = 1e-6

kernel_name = "hybrid_stickbreak_dilated_sandwich_trunk"


def rms_norm(x, gain):
    xf = x.astype(jnp.float32)
    y = xf * lax.rsqrt(jnp.mean(xf * xf, axis=-1, keepdims=True) + RMS_EPS)
    return (y * gain.astype(jnp.float32)).astype(x.dtype)


def t5_bucket(dist):
    max_exact = NUM_BUCKETS // 2
    d = jnp.maximum(dist, 1).astype(jnp.float32)
    large = max_exact + (jnp.log(d / max_exact) / math.log(MAX_DISTANCE / max_exact)
                         * (NUM_BUCKETS - max_exact)).astype(jnp.int32)
    large = jnp.minimum(large, NUM_BUCKETS - 1)
    return jnp.where(dist < max_exact, dist, large)


def stick_breaking_attention(q, k, v):
    b, s, h, e = q.shape
    nblk = s // BLOCK
    scale = 1.0 / math.sqrt(e)
    kt = k.transpose(0, 2, 1, 3)
    vt = v.transpose(0, 2, 1, 3).astype(jnp.float32)
    qb = q.reshape(b, nblk, BLOCK, h, e).transpose(1, 0, 3, 2, 4)
    starts = jnp.arange(nblk, dtype=jnp.int32) * BLOCK
    key_pos = jnp.arange(s, dtype=jnp.int32)

    def one_block(args):
        qi, t0 = args
        z = jnp.einsum('bhqe,bhke->bhqk', qi, kt).astype(jnp.float32) * scale
        q_pos = t0 + jnp.arange(BLOCK, dtype=jnp.int32)
        earlier = key_pos[None, :] < q_pos[:, None]
        log_keep = jnp.where(earlier, jax.nn.log_sigmoid(-z), 0.0)
        later = lax.cumsum(log_keep, axis=3, reverse=True) - log_keep
        a = jnp.where(earlier, jnp.exp(jax.nn.log_sigmoid(z) + later), 0.0)
        return jnp.einsum('bhqk,bhke->bhqe', a, vt)

    o = lax.map(one_block, (qb, starts))
    return o.transpose(1, 0, 3, 2, 4).reshape(b, s, h, e).astype(q.dtype)


def dilated_branch(q, k, v, rel_bias, window, dilation):
    b, s, h, e = q.shape
    span = dilation * BLOCK
    s_pad = -(-s // span) * span
    nb = s_pad // span
    n_back = window // dilation
    scale = 1.0 / math.sqrt(e)

    def to_sub(t):
        t = jnp.pad(t, ((0, 0), (0, s_pad - s), (0, 0), (0, 0)))
        return t.reshape(b, nb, BLOCK, dilation, h, e).transpose(0, 3, 4, 1, 2, 5)

    def with_prev(t):
        prev = jnp.pad(t[:, :, :, :-1], ((0, 0), (0, 0), (0, 0), (1, 0), (0, 0), (0, 0)))
        return jnp.concatenate([prev, t], axis=4)

    qs = to_sub(q)
    kk = with_prev(to_sub(k))
    vv = with_prev(to_sub(v)).astype(jnp.float32)
    logits = jnp.einsum('brhnqe,brhnke->brhnqk', qs, kk).astype(jnp.float32) * scale

    qi = jnp.arange(BLOCK, dtype=jnp.int32)[:, None]
    ki = jnp.arange(2 * BLOCK, dtype=jnp.int32)[None, :]
    rel = BLOCK + qi - ki
    band = (rel >= 0) & (rel <= n_back)
    bias = rel_bias.astype(jnp.float32)[t5_bucket(jnp.maximum(rel, 0) * dilation)]
    bias = bias.transpose(2, 0, 1)[:, None]
    has_prev = (jnp.arange(nb)[:, None, None] > 0) | (ki[None] >= BLOCK)
    valid = band[None] & has_prev

    logits = jnp.where(valid, logits + bias, -jnp.inf)
    m = jnp.max(logits, axis=-1, keepdims=True)
    p = jnp.exp(logits - m)
    denom = jnp.sum(p, axis=-1, keepdims=True)
    o = jnp.einsum('brhnqk,brhnke->brhnqe', p, vv) / denom
    lse = m + jnp.log(denom)

    def from_sub(t):
        return t.transpose(0, 3, 4, 1, 2, 5).reshape(b, s_pad, h, t.shape[-1])[:, :s]

    return from_sub(o), from_sub(lse)[..., 0]


def dilated_mixture(q, k, v, rel_bias):
    outs, lses = [], []
    for window, dilation in DIL_GROUPS:
        o, l = dilated_branch(q, k, v, rel_bias, window, dilation)
        outs.append(o)
        lses.append(l)
    w = jax.nn.softmax(jnp.stack(lses, axis=0), axis=0)
    o = jnp.sum(w[..., None] * jnp.stack(outs, axis=0), axis=0)
    return o.astype(q.dtype)


def setup_inputs(seed: int = 0) -> dict:
    key = jax.random.key(seed)
    ks = jax.random.split(key, 15)

    def normal(k, shape, scale):
        return jax.random.normal(k, shape, jnp.float32) * scale

    def gain(k, shape):
        return 1.0 + normal(k, shape, 0.01)

    return {
        "x": normal(ks[0], (BATCH, SEQ, D_MODEL), 1.0),
        "p": normal(ks[1], (DEPTH, BATCH, SEQ, PLI_DIM), 1.0),
        "ln_mix_pre": gain(ks[2], (DEPTH, D_MODEL)),
        "w_in": normal(ks[3], (DEPTH, D_MODEL, IN_WIDTH), D_MODEL ** -0.5),
        "ln_head": gain(ks[4], (DEPTH, MIX_WIDTH)),
        "w_out": normal(ks[5], (DEPTH, MIX_WIDTH, D_MODEL), MIX_WIDTH ** -0.5),
        "ln_mix_post": gain(ks[6], (DEPTH, D_MODEL)),
        "rel_bias": normal(ks[7], (NUM_BUCKETS, N_HEADS_DIL), 0.5),
        "ln_ffn_pre": gain(ks[8], (DEPTH, D_MODEL)),
        "w_gate_up": normal(ks[9], (DEPTH, D_MODEL, 2 * D_FF), D_MODEL ** -0.5),
        "w_down": normal(ks[10], (DEPTH, D_FF, D_MODEL), D_FF ** -0.5),
        "ln_ffn_post": gain(ks[11], (DEPTH, D_MODEL)),
        "ln_pli": gain(ks[12], (DEPTH, D_MODEL)),
        "w_pli_gate": normal(ks[13], (DEPTH, D_MODEL, D_MODEL), D_MODEL ** -0.5),
        "w_pli_proj": normal(ks[14], (DEPTH, PLI_DIM, D_MODEL), PLI_DIM ** -0.5),
    }


def reference(x, p, ln_mix_pre, w_in, ln_head, w_out, ln_mix_post, rel_bias,
              ln_ffn_pre, w_gate_up, w_down, ln_ffn_post, ln_pli, w_pli_gate, w_pli_proj):
    b, s, _ = x.shape
    for i in range(DEPTH):
        h = rms_norm(x, ln_mix_pre[i])
        proj = h @ w_in[i]
        q_sb, k_sb, v_sb, q_dl, k_dl, v_dl = jnp.split(proj, list(IN_SPLITS), axis=-1)
        sb_shape = (b, s, N_HEADS_SB, HEAD_DIM)
        dl_shape = (b, s, N_HEADS_DIL, HEAD_DIM)
        o_sb = stick_breaking_attention(q_sb.reshape(sb_shape), k_sb.reshape(sb_shape), v_sb.reshape(sb_shape))
        o_dl = dilated_mixture(q_dl.reshape(dl_shape), k_dl.reshape(dl_shape), v_dl.reshape(dl_shape), rel_bias)
        o = jnp.concatenate([o_sb, o_dl], axis=2)
        o = rms_norm(o, ln_head[i].reshape(N_HEADS_TOTAL, HEAD_DIM)).reshape(b, s, MIX_WIDTH)
        x = x + rms_norm(o @ w_out[i], ln_mix_post[i])
        h = rms_norm(x, ln_ffn_pre[i])
        g, u = jnp.split(h @ w_gate_up[i], 2, axis=-1)
        f = (jax.nn.silu(g) * u) @ w_down[i]
        x = x + rms_norm(f, ln_ffn_post[i])
        gate = jax.nn.sigmoid(rms_norm(x, ln_pli[i]) @ w_pli_gate[i])
        x = x + gate * (p[i] @ w_pli_proj[i])
    return x
```

```cpp
#define MK_N_LAUNCHES 37
#include <hip/hip_runtime.h>
#include <cstdio>
#include <cstdint>
namespace pg8 {
#define PG8_LAS __attribute__((address_space(3)))
typedef unsigned short bf16_t;
typedef short bf16x8 __attribute__((ext_vector_type(8)));
typedef float f32x4 __attribute__((ext_vector_type(4)));
typedef unsigned u32x4 __attribute__((ext_vector_type(4)));
constexpr int BM = 256, BK = 64, HALF = 128, HTB = HALF * BK * 2  , STAGE_BYTES = 8 * HTB, NXCD = 8, WGM = 8;

__host__ __device__ __forceinline__ int lds_byte(int r, int c) { const int st = (r >> 4) * 2 + (c >> 5), rr = r & 15, cc = c & 31, ob = rr * 64 + cc * 2; return st * 1024 + (ob ^ (((ob >> 9) & 1) << 5)); }
__host__ __device__ __forceinline__ void stage_rc(int b, int& R, int& C) { const int st = b / 1024, sb = b % 1024, swz = sb ^ (((sb >> 9) & 1) << 5); R = (st >> 1) * 16 + swz / 64; C = (st & 1) * 32 + (swz % 64) / 2; }
__host__ __device__ __forceinline__ int perm32(int rho) { const int n = rho >> 4, i = rho & 15; return 8 * (i >> 2) + 4 * n + (i & 3); }

struct Unit { int pm, pn; };
struct Gemm { const bf16_t* A; const bf16_t* Bt; int M, N, K; };

struct StaticOrder {
    int nM, nN, nwg, G, c;
    __host__ __device__ void init(int M, int N, int G_, int c_) { nM = M / BM; nN = N / BM; nwg = nM * nN; G = G_; c = c_; }
    __host__ __device__ bool next(int i, Unit& u) const {
        const long L = (long)i * G + c; if (L >= nwg) return false;
        int wgid = (int)L; { const int q = nwg / NXCD, r = nwg % NXCD, xcd = wgid % NXCD, off = wgid / NXCD; wgid = (xcd < r ? xcd * (q + 1) : r * (q + 1) + (xcd - r) * q) + off; }
        const int nig = WGM * nN, gid = wgid / nig, fm = gid * WGM, gsz = (nM - fm) < WGM ? (nM - fm) : WGM;
        u.pm = fm + ((wgid % nig) % gsz); u.pn = (wgid % nig) / gsz; return true;
    }
    __device__ __forceinline__ void a_ready(const Unit&) const {}
    __device__ __forceinline__ void done(const Unit&) const {}
};

__device__ __forceinline__ unsigned cvt_pk_bf16(float lo, float hi) { unsigned r; asm volatile("v_cvt_pk_bf16_f32 %0, %1, %2" : "=v"(r) : "v"(lo), "v"(hi)); return r; }
typedef float f32x2 __attribute__((ext_vector_type(2)));
__device__ __forceinline__ f32x2 gelu_pk(f32x2 v) {
    const f32x2 av = __builtin_elementwise_abs(v), d = av * 0.2316418882f + 1.0f;
    f32x2 t; t.x = __builtin_amdgcn_rcpf(d.x); t.y = __builtin_amdgcn_rcpf(d.y);
    f32x2 q = t * 0.5307027145f + (-0.7265760135f); q = q * t + 0.7107068705f; q = q * t + (-0.142248368f); q = q * t + 0.127414796f; q = q * t;
    const f32x2 s = (v * v) * (-0.72134752044f);
    f32x2 e; e.x = __builtin_amdgcn_exp2f(s.x); e.y = __builtin_amdgcn_exp2f(s.y);
    const f32x2 m = v * (q * e), r = v - m;
    f32x2 o; o.x = v.x < 0.f ? m.x : r.x; o.y = v.y < 0.f ? m.y : r.y; return o;
}

template <int ACT  > struct EpiBf16 {
    static constexpr bool PERM = true, AFTER_DRAIN = false; static_assert(ACT == 0 || ACT == 1, "EpiBf16: ACT is 0 (none) or 1 (gelu_pk)");
    bf16_t* O; int ldc; const float* bias; int split_cols; size_t split_stride; float scale0;
    __device__ __forceinline__ void operator()(const f32x4 (&acc)[2][2][4][2], const Unit& u, int wr, int wc, int fr, int fq) const {
        const int row0 = u.pm * BM + wr * 64 + fr; int colt = u.pn * BM; bf16_t* base = O;
        float sc = 1.f; if (split_cols) { const int t = colt / split_cols; base += (size_t)t * split_stride; colt -= t * split_cols; if (t == 0) sc = scale0; }
        const int col0 = colt + wc * 32 + 8 * fq, bcol0 = u.pn * BM + wc * 32 + 8 * fq;
        f32x4 bv[2][2];
#pragma unroll
        for (int bj = 0; bj < 2; ++bj)
#pragma unroll
            for (int n = 0; n < 2; ++n) bv[bj][n] = bias ? *(const f32x4*)(bias + bcol0 + bj * HALF + 4 * n) : (f32x4){0.f, 0.f, 0.f, 0.f};
#pragma unroll
        for (int ai = 0; ai < 2; ++ai)
#pragma unroll
            for (int m = 0; m < 4; ++m) { bf16_t* rowp = base + (size_t)(row0 + ai * HALF + m * 16) * ldc + col0;
#pragma unroll
                for (int bj = 0; bj < 2; ++bj) { f32x4 v0 = acc[ai][bj][m][0] + bv[bj][0], v1 = acc[ai][bj][m][1] + bv[bj][1];
                    if (ACT == 1) { f32x2 a = gelu_pk((f32x2){v0[0], v0[1]}), b = gelu_pk((f32x2){v0[2], v0[3]}), c = gelu_pk((f32x2){v1[0], v1[1]}), d = gelu_pk((f32x2){v1[2], v1[3]});
                        v0 = (f32x4){a.x, a.y, b.x, b.y}; v1 = (f32x4){c.x, c.y, d.x, d.y}; }
                    v0 = v0 * sc; v1 = v1 * sc; u32x4 w; w.x = cvt_pk_bf16(v0[0], v0[1]); w.y = cvt_pk_bf16(v0[2], v0[3]); w.z = cvt_pk_bf16(v1[0], v1[1]); w.w = cvt_pk_bf16(v1[2], v1[3]);
                    *(u32x4*)(rowp + bj * HALF) = w; } }
    }
};
struct EpiStore {
    static constexpr bool PERM = true, AFTER_DRAIN = false;
    bf16_t* O; int ldc;
    __device__ __forceinline__ void operator()(const f32x4 (&acc)[2][2][4][2], const Unit& u, int wr, int wc, int fr, int fq) const {
        const int row0 = u.pm * BM + wr * 64 + fr, col0 = u.pn * BM + wc * 32 + 8 * fq;
#pragma unroll
        for (int ai = 0; ai < 2; ++ai)
#pragma unroll
            for (int m = 0; m < 4; ++m) { bf16_t* rowp = O + (size_t)(row0 + ai * HALF + m * 16) * ldc + col0;
#pragma unroll
                for (int bj = 0; bj < 2; ++bj) { const f32x4 v0 = acc[ai][bj][m][0], v1 = acc[ai][bj][m][1];
                    u32x4 w; w.x = cvt_pk_bf16(v0[0], v0[1]); w.y = cvt_pk_bf16(v0[2], v0[3]); w.z = cvt_pk_bf16(v1[0], v1[1]); w.w = cvt_pk_bf16(v1[2], v1[3]);
                    *(u32x4*)(rowp + bj * HALF) = w; } }
    }
};
__device__ __forceinline__ float sigmoid_f(float v) { return __builtin_amdgcn_rcpf(1.0f + __builtin_amdgcn_exp2f(-1.44269504089f * v)); }
struct EpiSwiGLU {
    static constexpr bool PERM = true, AFTER_DRAIN = false;
    bf16_t* O; int ldc;
    __device__ __forceinline__ void operator()(const f32x4 (&acc)[2][2][4][2], const Unit& u, int wr, int wc, int fr, int fq) const {
        const int row0 = u.pm * BM + wr * 64 + fr, col0 = u.pn * HALF + wc * 32 + 8 * fq;
#pragma unroll
        for (int ai = 0; ai < 2; ++ai)
#pragma unroll
            for (int m = 0; m < 4; ++m) { bf16_t* rowp = O + (size_t)(row0 + ai * HALF + m * 16) * ldc + col0;
                f32x4 r0, r1; const f32x4 g0 = acc[ai][0][m][0], g1 = acc[ai][0][m][1], u0 = acc[ai][1][m][0], u1 = acc[ai][1][m][1];
#pragma unroll
                for (int j = 0; j < 4; ++j) { r0[j] = g0[j] * sigmoid_f(g0[j]) * u0[j]; r1[j] = g1[j] * sigmoid_f(g1[j]) * u1[j]; }
                u32x4 w; w.x = cvt_pk_bf16(r0[0], r0[1]); w.y = cvt_pk_bf16(r0[2], r0[3]); w.z = cvt_pk_bf16(r1[0], r1[1]); w.w = cvt_pk_bf16(r1[2], r1[3]);
                *(u32x4*)rowp = w; }
    }
};
struct EpiPli {
    static constexpr bool PERM = true, AFTER_DRAIN = false;
    float* X; const bf16_t* PP; int ldc;
    __device__ __forceinline__ void operator()(const f32x4 (&acc)[2][2][4][2], const Unit& u, int wr, int wc, int fr, int fq) const {
        const int row0 = u.pm * BM + wr * 64 + fr, col0 = u.pn * BM + wc * 32 + 8 * fq;
#pragma unroll
        for (int ai = 0; ai < 2; ++ai)
#pragma unroll
            for (int m = 0; m < 4; ++m) { const size_t off = (size_t)(row0 + ai * HALF + m * 16) * ldc + col0;
#pragma unroll
                for (int bj = 0; bj < 2; ++bj) { const f32x4 a0 = acc[ai][bj][m][0], a1 = acc[ai][bj][m][1];
                    const u32x4 pp = *(const u32x4*)(PP + off + bj * HALF);
                    f32x4 x0 = *(const f32x4*)(X + off + bj * HALF), x1 = *(const f32x4*)(X + off + bj * HALF + 4);
                    x0[0] += sigmoid_f(a0[0]) * __uint_as_float(pp.x << 16); x0[1] += sigmoid_f(a0[1]) * __uint_as_float(pp.x & 0xffff0000u);
                    x0[2] += sigmoid_f(a0[2]) * __uint_as_float(pp.y << 16); x0[3] += sigmoid_f(a0[3]) * __uint_as_float(pp.y & 0xffff0000u);
                    x1[0] += sigmoid_f(a1[0]) * __uint_as_float(pp.z << 16); x1[1] += sigmoid_f(a1[1]) * __uint_as_float(pp.z & 0xffff0000u);
                    x1[2] += sigmoid_f(a1[2]) * __uint_as_float(pp.w << 16); x1[3] += sigmoid_f(a1[3]) * __uint_as_float(pp.w & 0xffff0000u);
                    *(f32x4*)(X + off + bj * HALF) = x0; *(f32x4*)(X + off + bj * HALF + 4) = x1; }
                asm volatile("" ::: "memory"); }
    }
};
template <class Epi, class Sched, bool ALIGN_EPI = false, bool SP2 = false>
__device__ __forceinline__ void gemm_phase(PG8_LAS unsigned char* lds, const Gemm g, const Sched& S, const Epi& E) {
    int tid_ = threadIdx.x; asm volatile("" : "+v"(tid_));
    const int tid = tid_, wid = __builtin_amdgcn_readfirstlane(tid >> 6), lane = tid & 63, wr = wid >> 2, wc = wid & 3, fr = lane & 15, fq = lane >> 4;
    int K_ = g.K; asm volatile("" : "+s"(K_));
    const int K = K_, nt = K / BK;
    unsigned voffA[2], voffB[2];
#pragma unroll
    for (int i = 0; i < 2; ++i) { int R, C; stage_rc(tid * 16 + i * 8192, R, C); const int Rb = Epi::PERM ? ((R & ~31) + perm32(R & 31)) : R;
        voffA[i] = (unsigned)(R * K + C) * 2u; voffB[i] = (unsigned)(Rb * K + C) * 2u; }
    const size_t kstep = (size_t)(BK * 2);
    const size_t hstep = (size_t)HALF * K * 2;
    const size_t tstep = 2 * hstep;
    const unsigned ldsw = (unsigned)wid * 1024u;
    const int aoff = lds_byte(wr * 64 + fr, fq * 8), boff = lds_byte(wc * 32 + fr, fq * 8);
#define PG8_SA(b, h) (((b) * 2 + (h)) * HTB)
#define PG8_SB(b, h) ((4 + (b) * 2 + (h)) * HTB)
#define PG8_STAGE(bufoff, gbase, voff) do { _Pragma("unroll") for (int _i = 0; _i < 2; ++_i) \
        __builtin_amdgcn_global_load_lds((const unsigned*)((const char*)(gbase) + (voff)[_i]), (PG8_LAS unsigned*)(lds + (bufoff) + ldsw + _i * 8192), 16, 0, 0); } while (0)
#define PG8_LDA(dst, b, h) do { _Pragma("unroll") for (int m = 0; m < 4; ++m) _Pragma("unroll") for (int k = 0; k < 2; ++k) dst[m][k] = *(const PG8_LAS bf16x8*)(lds + PG8_SA(b, h) + aoff + m * 2048 + k * 1024); } while (0)
#define PG8_LDB(dst, b, h) do { _Pragma("unroll") for (int n = 0; n < 2; ++n) _Pragma("unroll") for (int k = 0; k < 2; ++k) dst[n][k] = *(const PG8_LAS bf16x8*)(lds + PG8_SB(b, h) + boff + n * 2048 + k * 1024); } while (0)
#define PG8_MMA(ai, bj, At, Bt) do { __builtin_amdgcn_s_setprio(1); _Pragma("unroll") for (int m = 0; m < 4; ++m) _Pragma("unroll") for (int n = 0; n < 2; ++n) _Pragma("unroll") for (int k = 0; k < 2; ++k) \
        acc[ai][bj][m][n] = __builtin_amdgcn_mfma_f32_16x16x32_bf16(Bt[n][k], At[m][k], acc[ai][bj][m][n], 0, 0, 0); __builtin_amdgcn_s_setprio(0); } while (0)
#define PG8_WAIT_V(n) asm volatile("s_waitcnt vmcnt(" #n ")" ::: "memory")
#define PG8_WAIT_L(n) asm volatile("s_waitcnt lgkmcnt(" #n ")" ::: "memory")
#define PG8_BAR __builtin_amdgcn_s_barrier()
#define PG8_SCHED __builtin_amdgcn_sched_barrier(0)
    Unit cur, nxt; int ui = 0;
    if (!S.next(0, cur)) return;
    f32x4 acc[2][2][4][2];
#pragma unroll
    for (int a = 0; a < 2; ++a)
#pragma unroll
        for (int b = 0; b < 2; ++b)
#pragma unroll
            for (int m = 0; m < 4; ++m)
#pragma unroll
                for (int n = 0; n < 2; ++n) acc[a][b][m][n] = (f32x4){0.f, 0.f, 0.f, 0.f};
    bf16x8 At[4][2], B0[2][2], B1[2][2];
    const char* cA = (const char*)g.A + (size_t)cur.pm * tstep; const char* cB = (const char*)g.Bt + (size_t)cur.pn * tstep;
    S.a_ready(cur);
    if constexpr (SP2) {
        PG8_STAGE(PG8_SB(0, 0), cB, voffB); PG8_STAGE(PG8_SB(0, 1), cB + hstep, voffB); PG8_STAGE(PG8_SA(0, 0), cA, voffA); PG8_STAGE(PG8_SA(0, 1), cA + hstep, voffA);
        if (wr == 1) PG8_BAR;
        PG8_WAIT_V(2); PG8_BAR;
        PG8_STAGE(PG8_SB(1, 0), cB + kstep, voffB); PG8_STAGE(PG8_SA(1, 0), cA + kstep, voffA); PG8_STAGE(PG8_SB(1, 1), cB + hstep + kstep, voffB);
        PG8_WAIT_V(6); PG8_BAR;
    } else {
        PG8_STAGE(PG8_SB(0, 0), cB, voffB); PG8_STAGE(PG8_SA(0, 0), cA, voffA); PG8_STAGE(PG8_SB(0, 1), cB + hstep, voffB); PG8_STAGE(PG8_SA(0, 1), cA + hstep, voffA);
        if (wr == 1) PG8_BAR;
        PG8_WAIT_V(4); PG8_BAR;
        PG8_STAGE(PG8_SB(1, 0), cB + kstep, voffB); PG8_STAGE(PG8_SA(1, 0), cA + kstep, voffA); PG8_STAGE(PG8_SB(1, 1), cB + hstep + kstep, voffB);
        PG8_WAIT_V(6); PG8_BAR;
    }
    for (;;) {
        const bool has_next = S.next(ui + 1, nxt);
        const char* nA = has_next ? (const char*)g.A + (size_t)nxt.pm * tstep : cA; const char* nB = has_next ? (const char*)g.Bt + (size_t)nxt.pn * tstep : cB;
        _Pragma("unroll 1") for (int t = 0; t < nt; t += 2) {
            const bool last = (t == nt - 2);
            const char* a1 = cA + (size_t)(t + 1) * kstep;
            const char* a2 = last ? nA : cA + (size_t)(t + 2) * kstep; const char* b2 = last ? nB : cB + (size_t)(t + 2) * kstep;
            const char* a3 = a2 + kstep; const char* b3 = b2 + kstep;
            if (last && has_next) S.a_ready(nxt);
            if constexpr (SP2) {
            PG8_LDB(B0, 0, 0); PG8_LDB(B1, 0, 1); PG8_SCHED; PG8_LDA(At, 0, 0); PG8_STAGE(PG8_SA(1, 1), a1 + hstep, voffA);
            PG8_WAIT_V(8); PG8_WAIT_L(0); PG8_BAR; PG8_MMA(0, 0, At, B0); PG8_MMA(0, 1, At, B1); PG8_BAR; PG8_SCHED;
            PG8_LDA(At, 0, 1); PG8_STAGE(PG8_SB(0, 0), b2, voffB); PG8_STAGE(PG8_SB(0, 1), b2 + hstep, voffB); PG8_STAGE(PG8_SA(0, 0), a2, voffA);
            PG8_WAIT_V(8); PG8_WAIT_L(0); PG8_BAR; PG8_MMA(1, 0, At, B0); PG8_MMA(1, 1, At, B1); PG8_BAR; PG8_SCHED;
            PG8_LDB(B0, 1, 0); PG8_LDB(B1, 1, 1); PG8_SCHED; PG8_LDA(At, 1, 0); PG8_STAGE(PG8_SA(0, 1), a2 + hstep, voffA);
            PG8_WAIT_V(8); PG8_WAIT_L(0); PG8_BAR; PG8_MMA(0, 0, At, B0); PG8_MMA(0, 1, At, B1); PG8_BAR; PG8_SCHED;
            PG8_LDA(At, 1, 1); PG8_STAGE(PG8_SB(1, 0), b3, voffB); PG8_STAGE(PG8_SB(1, 1), b3 + hstep, voffB); PG8_STAGE(PG8_SA(1, 0), a3, voffA);
            PG8_WAIT_V(8); PG8_WAIT_L(0); PG8_BAR; PG8_MMA(1, 0, At, B0); PG8_MMA(1, 1, At, B1); PG8_BAR; PG8_SCHED;
            } else {
            PG8_LDB(B0, 0, 0); PG8_SCHED; PG8_LDA(At, 0, 0); PG8_STAGE(PG8_SA(1, 1), a1 + hstep, voffA);
            PG8_WAIT_L(8); PG8_BAR; PG8_WAIT_L(0); PG8_MMA(0, 0, At, B0); PG8_BAR; PG8_SCHED;
            PG8_LDB(B1, 0, 1); PG8_STAGE(PG8_SB(0, 0), b2, voffB);
            PG8_BAR; PG8_WAIT_L(0); PG8_MMA(0, 1, At, B1); PG8_BAR;
            PG8_LDA(At, 0, 1); PG8_STAGE(PG8_SA(0, 0), a2, voffA);
            PG8_BAR; PG8_WAIT_L(0); PG8_MMA(1, 0, At, B0); PG8_BAR; PG8_SCHED;
            PG8_STAGE(PG8_SB(0, 1), b2 + hstep, voffB);
            PG8_WAIT_V(6); PG8_BAR; PG8_MMA(1, 1, At, B1); PG8_BAR;
            PG8_LDB(B0, 1, 0); PG8_SCHED; PG8_LDA(At, 1, 0); PG8_STAGE(PG8_SA(0, 1), a2 + hstep, voffA);
            PG8_WAIT_L(8); PG8_BAR; PG8_WAIT_L(0); PG8_MMA(0, 0, At, B0); PG8_BAR; PG8_SCHED;
            PG8_LDB(B1, 1, 1); PG8_STAGE(PG8_SB(1, 0), b3, voffB);
            PG8_BAR; PG8_WAIT_L(0); PG8_MMA(0, 1, At, B1); PG8_BAR;
            PG8_LDA(At, 1, 1); PG8_STAGE(PG8_SA(1, 0), a3, voffA);
            PG8_BAR; PG8_WAIT_L(0); PG8_MMA(1, 0, At, B0); PG8_BAR; PG8_SCHED;
            PG8_STAGE(PG8_SB(1, 1), b3 + hstep, voffB);
            PG8_WAIT_V(6); PG8_BAR; PG8_MMA(1, 1, At, B1); PG8_BAR;
            }
        }
        if constexpr (ALIGN_EPI) { if (wr == 0) PG8_BAR; }
        if constexpr (!Epi::AFTER_DRAIN) { E(acc, cur, wr, wc, fr, fq); S.done(cur); }
        if (!has_next) break;
#pragma unroll
        for (int a = 0; a < 2; ++a)
#pragma unroll
            for (int b = 0; b < 2; ++b)
#pragma unroll
                for (int m = 0; m < 4; ++m)
#pragma unroll
                    for (int n = 0; n < 2; ++n) acc[a][b][m][n] = (f32x4){0.f, 0.f, 0.f, 0.f};
        cur = nxt; cA = nA; cB = nB; ++ui;
        if constexpr (ALIGN_EPI) { if (wr == 1) PG8_BAR; }
    }
    PG8_WAIT_V(0);
    if constexpr (!ALIGN_EPI) { if (wr == 0) PG8_BAR; }
    PG8_BAR;
    if constexpr (Epi::AFTER_DRAIN) { E.fused(acc, cur, wr, wc, fr, fq, lds, wid, lane); S.done(cur); }
#undef PG8_SA
#undef PG8_SB
#undef PG8_STAGE
#undef PG8_LDA
#undef PG8_LDB
#undef PG8_MMA
#undef PG8_WAIT_V
#undef PG8_WAIT_L
#undef PG8_BAR
#undef PG8_SCHED
}
}
#define GAS __attribute__((address_space(1)))
#define LAS __attribute__((address_space(3)))
typedef unsigned short bf16;
typedef unsigned v4u __attribute__((ext_vector_type(4)));
typedef float f32x4 __attribute__((ext_vector_type(4)));
typedef short bf16x8 __attribute__((ext_vector_type(8)));
typedef GAS unsigned gu32;
typedef GAS unsigned long long gu64;
#define RLX_AGENT __ATOMIC_RELAXED, __HIP_MEMORY_SCOPE_AGENT
#define LDS_WAIT() asm volatile("s_waitcnt lgkmcnt(0)" ::: "memory")
#define VM_WAIT() asm volatile("s_waitcnt vmcnt(0)" ::: "memory")
__device__ __forceinline__ unsigned long long rt() { return __builtin_amdgcn_s_memrealtime(); }
__device__ __forceinline__ unsigned f2bf(float f) { unsigned u = __builtin_bit_cast(unsigned, f); return (u + 0x7fffu + ((u >> 16) & 1u)) >> 16; }
__device__ __forceinline__ unsigned pk2(float lo, float hi) { return f2bf(lo) | (f2bf(hi) << 16); }

#define XB_TMO      128
#define XB_XCNT(j)  (256  + 64 * (j))
#define XB_XSUB(j)  (1280 + 64 * (j))
#define XB_XGEN(j)  (2304 + 64 * (j))
#define XB_TOP      3328
#define XB_TOPGEN   3392
#define XCD_BAR_WORDS 3456
#define XB_SPIN_CAP (1u << 18)

__device__ __forceinline__ unsigned xb_ld(unsigned* p)              { return __hip_atomic_load(p, __ATOMIC_RELAXED, __HIP_MEMORY_SCOPE_AGENT); }
__device__ __forceinline__ unsigned xb_add(unsigned* p, unsigned v) { return __hip_atomic_fetch_add(p, v, __ATOMIC_RELAXED, __HIP_MEMORY_SCOPE_AGENT); }
__device__ __forceinline__ unsigned xb_xcc_id() { return (unsigned)__builtin_amdgcn_s_getreg((3 << 11) | 20) & 0xFu; }
#define XB_SPIN(cond, bar) do { unsigned _sp = 0; while (cond) { __builtin_amdgcn_s_sleep(1); \
    if ((++_sp & 255u) == 0u) { if (xb_ld(&(bar)[XB_TMO])) break; if (_sp > XB_SPIN_CAP) { atomicAdd(&(bar)[XB_TMO], 1u); break; } } } } while (0)

struct XcdBarrier {
    unsigned* bar; unsigned x;
    volatile LAS unsigned* st;
};

__device__ __forceinline__ XcdBarrier xcd_barrier_post(unsigned* bar, volatile LAS unsigned* st) {
    XcdBarrier b; b.bar = bar; b.x = xb_xcc_id(); b.st = st;
    if (threadIdx.x == 0) (void)xb_add(&bar[XB_XCNT(b.x)], 1u);
    return b;
}
__device__ __forceinline__ void xcd_barrier_complete(unsigned* bar, unsigned x, unsigned& nloc, unsigned& nx) {
    const unsigned G = gridDim.x * gridDim.y * gridDim.z;
    unsigned sum, cnt, mine, sp = 0u;
    for (;;) {
        sum = 0u; cnt = 0u; mine = 0u;
#pragma unroll
        for (unsigned j = 0; j < 16; ++j) { const unsigned c = xb_ld(&bar[XB_XCNT(j)]); sum += c; cnt += (c > 0u) ? 1u : 0u; mine = (j == x) ? c : mine; }
        if (sum == G) break;
        __builtin_amdgcn_s_sleep(1);
        if ((++sp & 255u) == 0u) { if (xb_ld(&bar[XB_TMO])) break; if (sp > XB_SPIN_CAP) { atomicAdd(&bar[XB_TMO], 1u); break; } }
    }
    nloc = mine > 0u ? mine : 1u; nx = cnt > 0u ? cnt : 1u;
}

__device__ __forceinline__ void xcd_barrier(const XcdBarrier& b) {
    asm volatile("s_waitcnt vmcnt(0)" ::: "memory");
    __syncthreads();
    if (threadIdx.x == 0) {
        unsigned* bar = b.bar;
        __builtin_amdgcn_s_waitcnt(0);
        unsigned nloc = b.st[0], nx = b.st[1];
        if (nloc == 0u) { xcd_barrier_complete(bar, b.x, nloc, nx); b.st[0] = nloc; b.st[1] = nx; }
        const unsigned old = xb_add(&bar[XB_XSUB(b.x)], 1u);
        const unsigned gen = old / nloc;
        if (old + 1u == (gen + 1u) * nloc) {
            __builtin_amdgcn_fence(__ATOMIC_RELEASE, "agent");
            asm volatile("s_waitcnt vmcnt(0)" ::: "memory");
            const unsigned og = xb_add(&bar[XB_TOP], 1u);
            const unsigned tg = og / nx;
            if (og + 1u == (tg + 1u) * nx) xb_add(&bar[XB_TOPGEN], 1u);
            else XB_SPIN(xb_ld(&bar[XB_TOPGEN]) == tg, bar);
            __builtin_amdgcn_fence(__ATOMIC_ACQUIRE, "agent");
            xb_add(&bar[XB_XGEN(b.x)], 1u);
            asm volatile("s_waitcnt vmcnt(0)" ::: "memory");
        } else {
            XB_SPIN(xb_ld(&bar[XB_XGEN(b.x)]) == gen, bar);
            __builtin_amdgcn_fence(__ATOMIC_ACQUIRE, "agent");
            asm volatile("s_waitcnt vmcnt(0)" ::: "memory");
        }
    }
    __syncthreads();
}

constexpr int NWAVES = 8;
constexpr int BATCH = 8, SEQ = 4096, DM = 2048, DEPTH = 4, HD = 128, NHS = 8, NHD = 8, INW = 6144, DFF = 5632, PLI = 256;
constexpr int M = BATCH * SEQ;
constexpr float RMS_EPS = 1e-6f;
constexpr float QK_SCALE = 0.08838834764831845f;
constexpr float LOG2E = 1.4426950408889634f;
#ifndef MK_N_LAUNCHES
#define MK_N_LAUNCHES 1
#endif
constexpr int PH_PER_LAYER = 9, N_PHASES = 1 + DEPTH * PH_PER_LAYER;
constexpr size_t MiB = 1u << 20;
constexpr size_t WS_CTL = 0, CTL_ZERO_BYTES = 1 * MiB;
constexpr size_t WS_W = 1 * MiB, W_LAYER = 107 * MiB;
constexpr size_t WO_IN = 0, WO_OUT = 24 * MiB, WO_GU = 32 * MiB, WO_DN = 76 * MiB, WO_PG = 98 * MiB, WO_PP = 106 * MiB;
constexpr size_t WS_H = 432 * MiB;
constexpr size_t WS_PROJ = 560 * MiB;
constexpr size_t WS_O = 944 * MiB;
constexpr size_t WS_Y = 1072 * MiB;
constexpr size_t WS_P16 = 1200 * MiB;
constexpr size_t WS_DLP = 1216 * MiB;
constexpr size_t WS_LSE = 1344 * MiB;
constexpr size_t WS_END = 1346 * MiB;
constexpr int CW_TMO = 0, CW_CODE = 1, CW_BAR = 4096;
constexpr int RING_OFF = 0, RING_BYTES = 131072;
constexpr int LDSCTL_OFF = RING_BYTES, MISC_OFF = LDSCTL_OFF + 320;
constexpr int TAB_OFF = RING_BYTES + 1024;
constexpr int LDS_BYTES = 147456;

struct Frame {
    LAS unsigned char* lds;
    volatile LAS unsigned* MISC;
    gu32* ctl;
    int tid, lane, wave;
    int vcu, G;
};
struct Args { const float* in[15]; float* out; unsigned char* ws; int ph_lo, ph_hi, li, pad; };

__device__ __forceinline__ float wave_sum(float v) {
#pragma unroll
    for (int o = 1; o < 64; o <<= 1) v += __shfl_xor(v, o);
    return v;
}
__device__ __forceinline__ int opaque_v(int x) { asm volatile("" : "+v"(x)); return x; }
__device__ __forceinline__ float bf_lo(unsigned u) { return __uint_as_float(u << 16); }
__device__ __forceinline__ float bf_hi(unsigned u) { return __uint_as_float(u & 0xffff0000u); }

__device__ __forceinline__ void p0_transpose_item(const float* W, int K, int N, bf16* WT, int k0, int n0, int dst_row0, LAS float* scr, int lane) {
#pragma unroll 8
    for (int i = 0; i < 32; ++i) { const int kk = 2 * i + (lane >> 5); scr[kk * 33 + (lane & 31)] = W[(size_t)(k0 + kk) * N + n0 + (lane & 31)]; }
    LDS_WAIT(); asm volatile("" ::: "memory");
    const int c = lane & 7;
#pragma unroll
    for (int j = 0; j < 4; ++j) { const int n = (lane >> 3) + 8 * j; const LAS float* s = scr + (8 * c) * 33 + n;
        v4u o; o.x = pk2(s[0 * 33], s[1 * 33]); o.y = pk2(s[2 * 33], s[3 * 33]); o.z = pk2(s[4 * 33], s[5 * 33]); o.w = pk2(s[6 * 33], s[7 * 33]);
        *(GAS v4u*)(WT + (size_t)(dst_row0 + n) * K + k0 + 8 * c) = o; }
    LDS_WAIT(); asm volatile("" ::: "memory");
}
__device__ __forceinline__ void convert_weights(Frame& F, const Args& a) {
    LAS float* scr = (LAS float*)(F.lds + RING_OFF + F.wave * 16384);
    const int gw = F.vcu * NWAVES + F.wave, NGW = F.G * NWAVES, lane = opaque_v(F.lane);
    constexpr int I_IN = (DM / 64) * (INW / 32), I_OUT = (DM / 64) * (DM / 32), I_GU = (DM / 64) * (2 * DFF / 32), I_DN = (DFF / 64) * (DM / 32), I_PG = I_OUT, I_PP = (PLI / 64) * (DM / 32);
    constexpr int I_LAYER = I_IN + I_OUT + I_GU + I_DN + I_PG + I_PP;
    for (int it = gw; it < DEPTH * I_LAYER; it += NGW) {
        const int L = it / I_LAYER; int r = it % I_LAYER;
        unsigned char* wl = a.ws + WS_W + (size_t)L * W_LAYER;
        const float* W; int K, N; bf16* WT; bool gu = false;
        if (r < I_IN) { W = a.in[3] + (size_t)L * DM * INW; K = DM; N = INW; WT = (bf16*)(wl + WO_IN); }
        else if ((r -= I_IN) < I_OUT) { W = a.in[5] + (size_t)L * DM * DM; K = DM; N = DM; WT = (bf16*)(wl + WO_OUT); }
        else if ((r -= I_OUT) < I_GU) { W = a.in[9] + (size_t)L * DM * 2 * DFF; K = DM; N = 2 * DFF; WT = (bf16*)(wl + WO_GU); gu = true; }
        else if ((r -= I_GU) < I_DN) { W = a.in[10] + (size_t)L * DFF * DM; K = DFF; N = DM; WT = (bf16*)(wl + WO_DN); }
        else if ((r -= I_DN) < I_PG) { W = a.in[13] + (size_t)L * DM * DM; K = DM; N = DM; WT = (bf16*)(wl + WO_PG); }
        else { r -= I_PG; W = a.in[14] + (size_t)L * PLI * DM; K = PLI; N = DM; WT = (bf16*)(wl + WO_PP); }
        const int nblk = N / 32, kb = r / nblk, nb = r % nblk, k0 = 64 * kb, n0 = 32 * nb;
        int d0 = n0;
        if (gu) { d0 = (n0 < DFF) ? 256 * (n0 / 128) + (n0 % 128) : 256 * ((n0 - DFF) / 128) + 128 + ((n0 - DFF) % 128); }
        p0_transpose_item(W, K, N, WT, k0, n0, d0, scr, lane);
    }
}
struct Row32 { float v[4][8]; };
__device__ __forceinline__ void load_f32_row(const float* p, int lane, Row32& r) {
#pragma unroll
    for (int j = 0; j < 4; ++j) { const f32x4 a = *(const GAS f32x4*)(p + 512 * j + 8 * lane), b = *(const GAS f32x4*)(p + 512 * j + 8 * lane + 4);
        r.v[j][0] = a[0]; r.v[j][1] = a[1]; r.v[j][2] = a[2]; r.v[j][3] = a[3]; r.v[j][4] = b[0]; r.v[j][5] = b[1]; r.v[j][6] = b[2]; r.v[j][7] = b[3]; }
}
__device__ __forceinline__ void store_f32_row(float* p, int lane, const Row32& r) {
#pragma unroll
    for (int j = 0; j < 4; ++j) { f32x4 a, b; a[0] = r.v[j][0]; a[1] = r.v[j][1]; a[2] = r.v[j][2]; a[3] = r.v[j][3]; b[0] = r.v[j][4]; b[1] = r.v[j][5]; b[2] = r.v[j][6]; b[3] = r.v[j][7];
        *(GAS f32x4*)(p + 512 * j + 8 * lane) = a; *(GAS f32x4*)(p + 512 * j + 8 * lane + 4) = b; }
}
__device__ __forceinline__ void load_bf16_row(const bf16* p, int lane, Row32& r) {
#pragma unroll
    for (int j = 0; j < 4; ++j) { const v4u a = *(const GAS v4u*)(p + 512 * j + 8 * lane);
        r.v[j][0] = bf_lo(a.x); r.v[j][1] = bf_hi(a.x); r.v[j][2] = bf_lo(a.y); r.v[j][3] = bf_hi(a.y); r.v[j][4] = bf_lo(a.z); r.v[j][5] = bf_hi(a.z); r.v[j][6] = bf_lo(a.w); r.v[j][7] = bf_hi(a.w); }
}
__device__ __forceinline__ float row_sumsq(const Row32& r) {
    float s = 0.f;
#pragma unroll
    for (int j = 0; j < 4; ++j)
#pragma unroll
        for (int e = 0; e < 8; ++e) s += r.v[j][e] * r.v[j][e];
    return wave_sum(s);
}
__device__ __forceinline__ void store_norm_bf16(bf16* p, int lane, const Row32& x, float rstd, const Row32& g) {
#pragma unroll
    for (int j = 0; j < 4; ++j) { v4u o;
        o.x = pk2(x.v[j][0] * rstd * g.v[j][0], x.v[j][1] * rstd * g.v[j][1]); o.y = pk2(x.v[j][2] * rstd * g.v[j][2], x.v[j][3] * rstd * g.v[j][3]);
        o.z = pk2(x.v[j][4] * rstd * g.v[j][4], x.v[j][5] * rstd * g.v[j][5]); o.w = pk2(x.v[j][6] * rstd * g.v[j][6], x.v[j][7] * rstd * g.v[j][7]);
        *(GAS v4u*)(p + 512 * j + 8 * lane) = o; }
}
__device__ __forceinline__ void norm_only_phase(Frame& F, const float* xs, const float* gain, bf16* H) {
    const int gw = F.vcu * NWAVES + F.wave, NGW = F.G * NWAVES, lane = opaque_v(F.lane);
    Row32 g; load_f32_row(gain, lane, g);
    for (int m = gw; m < M; m += NGW) {
        Row32 x; load_f32_row(xs + (size_t)m * DM, lane, x);
        const float rstd = rsqrtf(row_sumsq(x) * (1.f / DM) + RMS_EPS);
        store_norm_bf16(H + (size_t)m * DM, lane, x, rstd, g);
    }
}
__device__ __forceinline__ void resid_norm_phase(Frame& F, const float* xs, float* xd, const bf16* Y, const float* gain1, const float* gain2, bf16* H, const float* prow, bf16* P16) {
    const int gw = F.vcu * NWAVES + F.wave, NGW = F.G * NWAVES, lane = opaque_v(F.lane);
    Row32 g1, g2; load_f32_row(gain1, lane, g1); load_f32_row(gain2, lane, g2);
    for (int m = gw; m < M; m += NGW) {
        Row32 y, x; load_bf16_row(Y + (size_t)m * DM, lane, y); load_f32_row(xs + (size_t)m * DM, lane, x);
        const float r1 = rsqrtf(row_sumsq(y) * (1.f / DM) + RMS_EPS);
#pragma unroll
        for (int j = 0; j < 4; ++j)
#pragma unroll
            for (int e = 0; e < 8; ++e) x.v[j][e] += y.v[j][e] * r1 * g1.v[j][e];
        store_f32_row(xd + (size_t)m * DM, lane, x);
        const float r2 = rsqrtf(row_sumsq(x) * (1.f / DM) + RMS_EPS);
        store_norm_bf16(H + (size_t)m * DM, lane, x, r2, g2);
        if (prow) { const f32x4 pv = *(const GAS f32x4*)(prow + (size_t)m * PLI + 4 * lane);
            unsigned long long w = (unsigned long long)pk2(pv[0], pv[1]) | ((unsigned long long)pk2(pv[2], pv[3]) << 32);
            *(GAS unsigned long long*)(P16 + (size_t)m * PLI + 4 * lane) = w; }
    }
}
__device__ __forceinline__ int t5_bucket(int dist) {
    if (dist < 16) return dist;
    const float v = logf((float)dist * (1.f / 16.f)) / 4.852030263919617f * 16.f;
    const int large = 16 + (int)v; return large < 31 ? large : 31;
}
__device__ __forceinline__ void sb_naive_item(const bf16* PROJ, bf16* O, const float* ghead, int b, int h, int qt, int lane) {
    const int i = lane & 31, dh = lane >> 5, t = 32 * qt + i;
    const size_t rowq = (size_t)b * SEQ + t;
    unsigned q[64];
    { const GAS v4u* qp = (const GAS v4u*)(PROJ + rowq * INW + h * HD);
#pragma unroll
      for (int c = 0; c < 16; ++c) { const v4u v = qp[c]; q[4 * c] = v.x; q[4 * c + 1] = v.y; q[4 * c + 2] = v.z; q[4 * c + 3] = v.w; } }
    float o[64];
#pragma unroll
    for (int d = 0; d < 64; ++d) o[d] = 0.f;
    float carry = 0.f;
    for (int j = 32 * qt + 30; j >= 0; --j) {
        const bf16* kr = PROJ + ((size_t)b * SEQ + j) * INW;
        const GAS v4u* kp = (const GAS v4u*)(kr + 1024 + h * HD);
        float dot = 0.f;
#pragma unroll
        for (int c = 0; c < 16; ++c) { const v4u kv = kp[c];
            dot += bf_lo(q[4 * c]) * bf_lo(kv.x) + bf_hi(q[4 * c]) * bf_hi(kv.x) + bf_lo(q[4 * c + 1]) * bf_lo(kv.y) + bf_hi(q[4 * c + 1]) * bf_hi(kv.y)
                 + bf_lo(q[4 * c + 2]) * bf_lo(kv.z) + bf_hi(q[4 * c + 2]) * bf_hi(kv.z) + bf_lo(q[4 * c + 3]) * bf_lo(kv.w) + bf_hi(q[4 * c + 3]) * bf_hi(kv.w); }
        const float z = dot * QK_SCALE;
        if (j < t) {
            const float sp = fmaxf(z, 0.f) + log1pf(expf(-fabsf(z)));
            const float a = expf(z - sp + carry);
            const GAS v4u* vp = (const GAS v4u*)(kr + 2048 + h * HD + dh * 64);
#pragma unroll
            for (int c = 0; c < 8; ++c) { const v4u vv = vp[c];
                o[8 * c] += a * bf_lo(vv.x); o[8 * c + 1] += a * bf_hi(vv.x); o[8 * c + 2] += a * bf_lo(vv.y); o[8 * c + 3] += a * bf_hi(vv.y);
                o[8 * c + 4] += a * bf_lo(vv.z); o[8 * c + 5] += a * bf_hi(vv.z); o[8 * c + 6] += a * bf_lo(vv.w); o[8 * c + 7] += a * bf_hi(vv.w); }
            carry -= sp;
        }
    }
    float ss = 0.f;
#pragma unroll
    for (int d = 0; d < 64; ++d) ss += o[d] * o[d];
    ss += __shfl_xor(ss, 32);
    const float rstd = rsqrtf(ss * (1.f / HD) + RMS_EPS);
    const float* gp = ghead + h * HD + dh * 64; bf16* op = O + rowq * DM + h * HD + dh * 64;
#pragma unroll
    for (int c = 0; c < 8; ++c) { const f32x4 ga = *(const GAS f32x4*)(gp + 8 * c), gb = *(const GAS f32x4*)(gp + 8 * c + 4); v4u w;
        w.x = pk2(o[8 * c] * rstd * ga[0], o[8 * c + 1] * rstd * ga[1]); w.y = pk2(o[8 * c + 2] * rstd * ga[2], o[8 * c + 3] * rstd * ga[3]);
        w.z = pk2(o[8 * c + 4] * rstd * gb[0], o[8 * c + 5] * rstd * gb[1]); w.w = pk2(o[8 * c + 6] * rstd * gb[2], o[8 * c + 7] * rstd * gb[3]);
        *(GAS v4u*)(op + 8 * c) = w; }
}
__device__ __forceinline__ void dl_naive_item(const bf16* PROJ, bf16* O, const float* ghead, const float* relb, int b, int hd, int qt, int lane) {
    const int i = lane & 31, dh = lane >> 5, t = 32 * qt + i;
    const size_t rowq = (size_t)b * SEQ + t;
    unsigned q[64];
    { const GAS v4u* qp = (const GAS v4u*)(PROJ + rowq * INW + 3072 + hd * HD);
#pragma unroll
      for (int c = 0; c < 16; ++c) { const v4u v = qp[c]; q[4 * c] = v.x; q[4 * c + 1] = v.y; q[4 * c + 2] = v.z; q[4 * c + 3] = v.w; } }
    float o[64];
#pragma unroll
    for (int d = 0; d < 64; ++d) o[d] = 0.f;
    float mx = -INFINITY, l = 0.f;
    for (int grp = 0; grp < 3; ++grp) {
        const int dil = grp == 0 ? 1 : (grp == 1 ? 4 : 16);
        for (int rel = 0; rel <= 128; ++rel) {
            const int kpos = t - rel * dil;
            const float bias = relb[t5_bucket(rel * dil) * NHD + hd];
            if (kpos >= 0) {
                const bf16* kr = PROJ + ((size_t)b * SEQ + kpos) * INW;
                const GAS v4u* kp = (const GAS v4u*)(kr + 4096 + hd * HD);
                float dot = 0.f;
#pragma unroll
                for (int c = 0; c < 16; ++c) { const v4u kv = kp[c];
                    dot += bf_lo(q[4 * c]) * bf_lo(kv.x) + bf_hi(q[4 * c]) * bf_hi(kv.x) + bf_lo(q[4 * c + 1]) * bf_lo(kv.y) + bf_hi(q[4 * c + 1]) * bf_hi(kv.y)
                         + bf_lo(q[4 * c + 2]) * bf_lo(kv.z) + bf_hi(q[4 * c + 2]) * bf_hi(kv.z) + bf_lo(q[4 * c + 3]) * bf_lo(kv.w) + bf_hi(q[4 * c + 3]) * bf_hi(kv.w); }
                const float lg = dot * QK_SCALE + bias;
                const float mn = fmaxf(mx, lg), al = expf(mx - mn), p = expf(lg - mn);
                l = l * al + p; mx = mn;
                const GAS v4u* vp = (const GAS v4u*)(kr + 5120 + hd * HD + dh * 64);
#pragma unroll
                for (int c = 0; c < 8; ++c) { const v4u vv = vp[c];
                    o[8 * c] = o[8 * c] * al + p * bf_lo(vv.x); o[8 * c + 1] = o[8 * c + 1] * al + p * bf_hi(vv.x); o[8 * c + 2] = o[8 * c + 2] * al + p * bf_lo(vv.y); o[8 * c + 3] = o[8 * c + 3] * al + p * bf_hi(vv.y);
                    o[8 * c + 4] = o[8 * c + 4] * al + p * bf_lo(vv.z); o[8 * c + 5] = o[8 * c + 5] * al + p * bf_hi(vv.z); o[8 * c + 6] = o[8 * c + 6] * al + p * bf_lo(vv.w); o[8 * c + 7] = o[8 * c + 7] * al + p * bf_hi(vv.w); }
            }
        }
    }
    const float inv = 1.f / l;
    float ss = 0.f;
#pragma unroll
    for (int d = 0; d < 64; ++d) { o[d] *= inv; ss += o[d] * o[d]; }
    ss += __shfl_xor(ss, 32);
    const float rstd = rsqrtf(ss * (1.f / HD) + RMS_EPS);
    const float* gp = ghead + 1024 + hd * HD + dh * 64; bf16* op = O + rowq * DM + 1024 + hd * HD + dh * 64;
#pragma unroll
    for (int c = 0; c < 8; ++c) { const f32x4 ga = *(const GAS f32x4*)(gp + 8 * c), gb = *(const GAS f32x4*)(gp + 8 * c + 4); v4u w;
        w.x = pk2(o[8 * c] * rstd * ga[0], o[8 * c + 1] * rstd * ga[1]); w.y = pk2(o[8 * c + 2] * rstd * ga[2], o[8 * c + 3] * rstd * ga[3]);
        w.z = pk2(o[8 * c + 4] * rstd * gb[0], o[8 * c + 5] * rstd * gb[1]); w.w = pk2(o[8 * c + 6] * rstd * gb[2], o[8 * c + 7] * rstd * gb[3]);
        *(GAS v4u*)(op + 8 * c) = w; }
}
__device__ __forceinline__ void attn_naive_phase(Frame& F, const bf16* PROJ, bf16* O, const float* ghead, const float* relb) {
    const int gw = F.vcu * NWAVES + F.wave, NGW = F.G * NWAVES, lane = opaque_v(F.lane);
    int k = 0;
    for (int it = gw; it < 16384; it += NGW, ++k) {
        const int r = it & 8191, b = r >> 10, h = (r >> 7) & 7; int qt = r & 127; if (k & 1) qt = 127 - qt;
        if (it < 8192) sb_naive_item(PROJ, O, ghead, b, h, qt, lane);
        else dl_naive_item(PROJ, O, ghead, relb, b, h, qt, lane);
    }
}

__global__ void __launch_bounds__(NWAVES * 64, 2) mega_fwd(Args args) {
    extern __shared__ __attribute__((aligned(16))) unsigned char lds[];
    Frame F;
    F.lds = (LAS unsigned char*)lds;
    F.MISC = (volatile LAS unsigned*)(F.lds + MISC_OFF);
    F.tid = threadIdx.x; F.lane = F.tid & 63; F.wave = __builtin_amdgcn_readfirstlane(F.tid >> 6);
    F.G = gridDim.x; { const int bx = blockIdx.x; F.vcu = (F.G % 8 == 0) ? (bx % 8) * (F.G / 8) + bx / 8 : bx; }
    unsigned char* ws = args.ws;
    F.ctl = (gu32*)(ws + WS_CTL);
    for (int u = F.tid; u < (LDS_BYTES - LDSCTL_OFF) / 4; u += NWAVES * 64) ((LAS unsigned*)(F.lds + LDSCTL_OFF))[u] = 0u;
    __syncthreads();
    const int lo = args.ph_lo, hi = args.ph_hi;
    const bool use_bar = (hi - lo) > 1;
    XcdBarrier bar; bar.bar = (unsigned*)(F.ctl + CW_BAR); bar.x = 0; bar.st = nullptr;
    if (use_bar) bar = xcd_barrier_post((unsigned*)(F.ctl + CW_BAR), F.MISC + 8);
#define IN(k) (lo <= (k) && (k) < hi)
#define SEAM(k) do { if (IN(k) && IN((k) + 1)) xcd_barrier(bar); } while (0)
    bf16* const H = (bf16*)(ws + WS_H); bf16* const PROJ = (bf16*)(ws + WS_PROJ); bf16* const ACT = (bf16*)(ws + WS_PROJ);
    bf16* const OB = (bf16*)(ws + WS_O); bf16* const Y = (bf16*)(ws + WS_Y); bf16* const P16 = (bf16*)(ws + WS_P16);
    float* const out = args.out;

    if (IN(0)) { convert_weights(F, args); norm_only_phase(F, args.in[0], args.in[2], H); }
    SEAM(0);
    for (int L = 0; L < DEPTH; ++L) {
        const int p0 = 1 + L * PH_PER_LAYER;
        unsigned char* wl = ws + WS_W + (size_t)L * W_LAYER;
        const float* xsrc = (L == 0) ? args.in[0] : out;
        if (IN(p0 + 0)) { pg8::Gemm g{H, (const bf16*)(wl + WO_IN), M, INW, DM}; pg8::StaticOrder S; S.init(M, INW, F.G, (int)blockIdx.x);
            pg8::EpiStore E{PROJ, INW}; pg8::gemm_phase<pg8::EpiStore, pg8::StaticOrder, true, true>(F.lds + RING_OFF, g, S, E); }
        SEAM(p0 + 0);
        if (IN(p0 + 1)) { attn_naive_phase(F, PROJ, OB, args.in[4] + (size_t)L * DM, args.in[7]); }
        SEAM(p0 + 1);
        if (IN(p0 + 2)) { pg8::Gemm g{OB, (const bf16*)(wl + WO_OUT), M, DM, DM}; pg8::StaticOrder S; S.init(M, DM, F.G, (int)blockIdx.x);
            pg8::EpiStore E{Y, DM}; pg8::gemm_phase<pg8::EpiStore, pg8::StaticOrder, true, true>(F.lds + RING_OFF, g, S, E); }
        SEAM(p0 + 2);
        if (IN(p0 + 3)) { resid_norm_phase(F, xsrc, out, Y, args.in[6] + (size_t)L * DM, args.in[8] + (size_t)L * DM, H, nullptr, nullptr); }
        SEAM(p0 + 3);
        if (IN(p0 + 4)) { pg8::Gemm g{H, (const bf16*)(wl + WO_GU), M, 2 * DFF, DM}; pg8::StaticOrder S; S.init(M, 2 * DFF, F.G, (int)blockIdx.x);
            pg8::EpiSwiGLU E{ACT, DFF}; pg8::gemm_phase<pg8::EpiSwiGLU, pg8::StaticOrder, true, true>(F.lds + RING_OFF, g, S, E); }
        SEAM(p0 + 4);
        if (IN(p0 + 5)) { pg8::Gemm g{ACT, (const bf16*)(wl + WO_DN), M, DM, DFF}; pg8::StaticOrder S; S.init(M, DM, F.G, (int)blockIdx.x);
            pg8::EpiStore E{Y, DM}; pg8::gemm_phase<pg8::EpiStore, pg8::StaticOrder, true, true>(F.lds + RING_OFF, g, S, E); }
        SEAM(p0 + 5);
        if (IN(p0 + 6)) { resid_norm_phase(F, out, out, Y, args.in[11] + (size_t)L * DM, args.in[12] + (size_t)L * DM, H, args.in[1] + (size_t)L * M * PLI, P16); }
        SEAM(p0 + 6);
        if (IN(p0 + 7)) {
            { pg8::Gemm g{P16, (const bf16*)(wl + WO_PP), M, DM, PLI}; pg8::StaticOrder S; S.init(M, DM, F.G, (int)blockIdx.x);
              pg8::EpiStore E{Y, DM}; pg8::gemm_phase<pg8::EpiStore, pg8::StaticOrder, true, true>(F.lds + RING_OFF, g, S, E); }
            __syncthreads();
            { pg8::Gemm g{H, (const bf16*)(wl + WO_PG), M, DM, DM}; pg8::StaticOrder S; S.init(M, DM, F.G, (int)blockIdx.x);
              pg8::EpiPli E{out, Y, DM}; pg8::gemm_phase<pg8::EpiPli, pg8::StaticOrder, true, true>(F.lds + RING_OFF, g, S, E); }
        }
        SEAM(p0 + 7);
        if (IN(p0 + 8) && L + 1 < DEPTH) { norm_only_phase(F, out, args.in[2] + (size_t)(L + 1) * DM, H); }
        SEAM(p0 + 8);
    }
#undef IN
#undef SEAM
}

extern "C" void kernel_launch(void* const* d_in, const int* in_sizes, int n_in, void* d_out, int out_size, void* d_ws, size_t ws_size, hipStream_t stream) {
    static int grid = 0;
    if (grid == 0) {
        if (n_in != 15 || in_sizes[0] != M * DM || out_size != M * DM || ws_size < WS_END) { fprintf(stderr, "kernel_launch: unexpected shapes or workspace (n_in %d, in0 %d, out %d, ws %zu < %zu); nothing launched\n", n_in, n_in > 0 ? in_sizes[0] : -1, out_size, ws_size, (size_t)WS_END); grid = -1; return; }
        int dev = 0, cus = 0, per_cu = 0;
        if (hipGetDevice(&dev) != hipSuccess || hipDeviceGetAttribute(&cus, hipDeviceAttributeMultiprocessorCount, dev) != hipSuccess) { fprintf(stderr, "kernel_launch: device query failed\n"); grid = -1; return; }
        if (hipFuncSetAttribute((const void*)mega_fwd, hipFuncAttributeMaxDynamicSharedMemorySize, LDS_BYTES) != hipSuccess) { fprintf(stderr, "kernel_launch: hipFuncSetAttribute failed\n"); grid = -1; return; }
        if (hipOccupancyMaxActiveBlocksPerMultiprocessor(&per_cu, (const void*)mega_fwd, NWAVES * 64, LDS_BYTES) != hipSuccess || per_cu < 1)
            fprintf(stderr, "kernel_launch: note: occupancy query reports %d workgroups per CU\n", per_cu);
        (void)hipGetLastError();
        grid = cus;
    }
    if (grid < 0) return;
    if (hipMemsetAsync((char*)d_ws + WS_CTL, 0, CTL_ZERO_BYTES, stream) != hipSuccess) { fprintf(stderr, "kernel_launch: memset failed\n"); return; }
    Args a{};
    for (int i = 0; i < 15; ++i) a.in[i] = (const float*)d_in[i];
    a.out = (float*)d_out; a.ws = (unsigned char*)d_ws;
#if MK_N_LAUNCHES == 1
    a.ph_lo = 0; a.ph_hi = N_PHASES; a.li = 0;
    hipLaunchKernelGGL(mega_fwd, dim3(grid), dim3(NWAVES * 64), LDS_BYTES, stream, a);
#else
    for (int p = 0; p < N_PHASES - 1; ++p) { a.ph_lo = p; a.ph_hi = p + 1; a.li = p;
        hipLaunchKernelGGL(mega_fwd, dim3(grid), dim3(NWAVES * 64), LDS_BYTES, stream, a); }
#endif
    const hipError_t le = hipPeekAtLastError();
    if (le != hipSuccess) fprintf(stderr, "kernel_launch: launch failed: %s\n", hipGetErrorName(le));
}
```

```cpp
#define MK_N_LAUNCHES 1
#include <hip/hip_runtime.h>
#include <cstdio>
#include <cstdint>
namespace pg8 {
#define PG8_LAS __attribute__((address_space(3)))
typedef unsigned short bf16_t;
typedef short bf16x8 __attribute__((ext_vector_type(8)));
typedef float f32x4 __attribute__((ext_vector_type(4)));
typedef unsigned u32x4 __attribute__((ext_vector_type(4)));
constexpr int BM = 256, BK = 64, HALF = 128, HTB = HALF * BK * 2  , STAGE_BYTES = 8 * HTB, NXCD = 8, WGM = 4;

__host__ __device__ __forceinline__ int lds_byte(int r, int c) { const int st = (r >> 4) * 2 + (c >> 5), rr = r & 15, cc = c & 31, ob = rr * 64 + cc * 2; return st * 1024 + (ob ^ (((ob >> 9) & 1) << 5)); }
__host__ __device__ __forceinline__ void stage_rc(int b, int& R, int& C) { const int st = b / 1024, sb = b % 1024, swz = sb ^ (((sb >> 9) & 1) << 5); R = (st >> 1) * 16 + swz / 64; C = (st & 1) * 32 + (swz % 64) / 2; }
__host__ __device__ __forceinline__ int perm32(int rho) { const int n = rho >> 4, i = rho & 15; return 8 * (i >> 2) + 4 * n + (i & 3); }

struct Unit { int pm, pn; };
struct Gemm { const bf16_t* A; const bf16_t* Bt; int M, N, K, lda; };

struct StaticOrder {
    int nM, nN, nwg, G, c;
    __host__ __device__ void init(int M, int N, int G_, int c_) { nM = M / BM; nN = N / BM; nwg = nM * nN; G = G_; c = c_; }
    __host__ __device__ bool next(int i, Unit& u) const {
        const long L = (long)i * G + c; if (L >= nwg) return false;
        int wgid = (int)L; { const int q = nwg / NXCD, r = nwg % NXCD, xcd = wgid % NXCD, off = wgid / NXCD; wgid = (xcd < r ? xcd * (q + 1) : r * (q + 1) + (xcd - r) * q) + off; }
        const int nig = WGM * nN, gid = wgid / nig, fm = gid * WGM, gsz = (nM - fm) < WGM ? (nM - fm) : WGM;
        u.pm = fm + ((wgid % nig) % gsz); u.pn = (wgid % nig) / gsz; return true;
    }
    __device__ __forceinline__ void a_ready(const Unit&) const {}
    __device__ __forceinline__ void done(const Unit&) const {}
};

__device__ __forceinline__ unsigned cvt_pk_bf16(float lo, float hi) { unsigned r; asm volatile("v_cvt_pk_bf16_f32 %0, %1, %2" : "=v"(r) : "v"(lo), "v"(hi)); return r; }
typedef float f32x2 __attribute__((ext_vector_type(2)));
__device__ __forceinline__ f32x2 gelu_pk(f32x2 v) {
    const f32x2 av = __builtin_elementwise_abs(v), d = av * 0.2316418882f + 1.0f;
    f32x2 t; t.x = __builtin_amdgcn_rcpf(d.x); t.y = __builtin_amdgcn_rcpf(d.y);
    f32x2 q = t * 0.5307027145f + (-0.7265760135f); q = q * t + 0.7107068705f; q = q * t + (-0.142248368f); q = q * t + 0.127414796f; q = q * t;
    const f32x2 s = (v * v) * (-0.72134752044f);
    f32x2 e; e.x = __builtin_amdgcn_exp2f(s.x); e.y = __builtin_amdgcn_exp2f(s.y);
    const f32x2 m = v * (q * e), r = v - m;
    f32x2 o; o.x = v.x < 0.f ? m.x : r.x; o.y = v.y < 0.f ? m.y : r.y; return o;
}

template <int ACT  > struct EpiBf16 {
    static constexpr bool PERM = true, AFTER_DRAIN = false; static_assert(ACT == 0 || ACT == 1, "EpiBf16: ACT is 0 (none) or 1 (gelu_pk)");
    bf16_t* O; int ldc; const float* bias; int split_cols; size_t split_stride; float scale0;
    __device__ __forceinline__ void operator()(const f32x4 (&acc)[2][2][4][2], const Unit& u, int wr, int wc, int fr, int fq) const {
        const int row0 = u.pm * BM + wr * 64 + fr; int colt = u.pn * BM; bf16_t* base = O;
        float sc = 1.f; if (split_cols) { const int t = colt / split_cols; base += (size_t)t * split_stride; colt -= t * split_cols; if (t == 0) sc = scale0; }
        const int col0 = colt + wc * 32 + 8 * fq, bcol0 = u.pn * BM + wc * 32 + 8 * fq;
        f32x4 bv[2][2];
#pragma unroll
        for (int bj = 0; bj < 2; ++bj)
#pragma unroll
            for (int n = 0; n < 2; ++n) bv[bj][n] = bias ? *(const f32x4*)(bias + bcol0 + bj * HALF + 4 * n) : (f32x4){0.f, 0.f, 0.f, 0.f};
#pragma unroll
        for (int ai = 0; ai < 2; ++ai)
#pragma unroll
            for (int m = 0; m < 4; ++m) { bf16_t* rowp = base + (size_t)(row0 + ai * HALF + m * 16) * ldc + col0;
#pragma unroll
                for (int bj = 0; bj < 2; ++bj) { f32x4 v0 = acc[ai][bj][m][0] + bv[bj][0], v1 = acc[ai][bj][m][1] + bv[bj][1];
                    if (ACT == 1) { f32x2 a = gelu_pk((f32x2){v0[0], v0[1]}), b = gelu_pk((f32x2){v0[2], v0[3]}), c = gelu_pk((f32x2){v1[0], v1[1]}), d = gelu_pk((f32x2){v1[2], v1[3]});
                        v0 = (f32x4){a.x, a.y, b.x, b.y}; v1 = (f32x4){c.x, c.y, d.x, d.y}; }
                    v0 = v0 * sc; v1 = v1 * sc; u32x4 w; w.x = cvt_pk_bf16(v0[0], v0[1]); w.y = cvt_pk_bf16(v0[2], v0[3]); w.z = cvt_pk_bf16(v1[0], v1[1]); w.w = cvt_pk_bf16(v1[2], v1[3]);
                    *(u32x4*)(rowp + bj * HALF) = w; } }
    }
};
struct EpiStore {
    static constexpr bool PERM = true, AFTER_DRAIN = false;
    bf16_t* O; int ldc;
    __device__ __forceinline__ void operator()(const f32x4 (&acc)[2][2][4][2], const Unit& u, int wr, int wc, int fr, int fq) const {
        const int row0 = u.pm * BM + wr * 64 + fr, col0 = u.pn * BM + wc * 32 + 8 * fq;
#pragma unroll
        for (int ai = 0; ai < 2; ++ai)
#pragma unroll
            for (int m = 0; m < 4; ++m) { bf16_t* rowp = O + (size_t)(row0 + ai * HALF + m * 16) * ldc + col0;
#pragma unroll
                for (int bj = 0; bj < 2; ++bj) { const f32x4 v0 = acc[ai][bj][m][0], v1 = acc[ai][bj][m][1];
                    u32x4 w; w.x = cvt_pk_bf16(v0[0], v0[1]); w.y = cvt_pk_bf16(v0[2], v0[3]); w.z = cvt_pk_bf16(v1[0], v1[1]); w.w = cvt_pk_bf16(v1[2], v1[3]);
                    *(u32x4*)(rowp + bj * HALF) = w; } }
    }
};
__device__ __forceinline__ float sigmoid_f(float v) { return __builtin_amdgcn_rcpf(1.0f + __builtin_amdgcn_exp2f(-1.44269504089f * v)); }
struct EpiSwiGLU {
    static constexpr bool PERM = true, AFTER_DRAIN = false;
    bf16_t* O; int ldc;
    __device__ __forceinline__ void operator()(const f32x4 (&acc)[2][2][4][2], const Unit& u, int wr, int wc, int fr, int fq) const {
        const int row0 = u.pm * BM + wr * 64 + fr, col0 = u.pn * HALF + wc * 32 + 8 * fq;
#pragma unroll
        for (int ai = 0; ai < 2; ++ai)
#pragma unroll
            for (int m = 0; m < 4; ++m) { bf16_t* rowp = O + (size_t)(row0 + ai * HALF + m * 16) * ldc + col0;
                f32x4 r0, r1; const f32x4 g0 = acc[ai][0][m][0], g1 = acc[ai][0][m][1], u0 = acc[ai][1][m][0], u1 = acc[ai][1][m][1];
#pragma unroll
                for (int j = 0; j < 4; ++j) { r0[j] = g0[j] * sigmoid_f(g0[j]) * u0[j]; r1[j] = g1[j] * sigmoid_f(g1[j]) * u1[j]; }
                u32x4 w; w.x = cvt_pk_bf16(r0[0], r0[1]); w.y = cvt_pk_bf16(r0[2], r0[3]); w.z = cvt_pk_bf16(r1[0], r1[1]); w.w = cvt_pk_bf16(r1[2], r1[3]);
                *(u32x4*)rowp = w; }
    }
};
typedef _Float16 h16x2 __attribute__((ext_vector_type(2)));
typedef float f32x2v __attribute__((ext_vector_type(2)));
__device__ __forceinline__ unsigned pkh2(float a, float b) { const f32x2v v = {a, b}; return __builtin_bit_cast(unsigned, __builtin_convertvector(v, h16x2)); }
__device__ __forceinline__ float h_lo(unsigned u) { return (float)__builtin_bit_cast(h16x2, u)[0]; }
__device__ __forceinline__ float h_hi(unsigned u) { return (float)__builtin_bit_cast(h16x2, u)[1]; }
struct EpiPli {
    static constexpr bool PERM = true, AFTER_DRAIN = false;
    const bf16_t* X; bf16_t* Xo; float* Of; const bf16_t* PP; int ldc;
    __device__ __forceinline__ void operator()(const f32x4 (&acc)[2][2][4][2], const Unit& u, int wr, int wc, int fr, int fq) const {
        const int row0 = u.pm * BM + wr * 64 + fr, col0 = u.pn * BM + wc * 32 + 8 * fq;
        u32x4 pp[3][2], xh[3][2];
#define PLI_LOAD(s) do { const size_t off_ = (size_t)(row0 + ((s) >> 2) * HALF + ((s) & 3) * 16) * ldc + col0; \
            pp[(s) % 3][0] = *(const u32x4*)(PP + off_); xh[(s) % 3][0] = *(const u32x4*)(X + off_); pp[(s) % 3][1] = *(const u32x4*)(PP + off_ + HALF); xh[(s) % 3][1] = *(const u32x4*)(X + off_ + HALF); } while (0)
        PLI_LOAD(0); PLI_LOAD(1);
#pragma unroll
        for (int s = 0; s < 8; ++s) {
            if (s + 2 < 8) PLI_LOAD(s + 2);
            asm volatile("" ::: "memory");
            const int ai = s >> 2, m = s & 3;
#pragma unroll
            for (int bj = 0; bj < 2; ++bj) { const size_t off = (size_t)(row0 + ai * HALF + m * 16) * ldc + col0 + bj * HALF;
                const f32x4 a0 = acc[ai][bj][m][0], a1 = acc[ai][bj][m][1]; const u32x4 p = pp[s % 3][bj], x = xh[s % 3][bj]; f32x4 y0, y1;
                y0[0] = h_lo(x.x) + sigmoid_f(a0[0]) * __uint_as_float(p.x << 16); y0[1] = h_hi(x.x) + sigmoid_f(a0[1]) * __uint_as_float(p.x & 0xffff0000u);
                y0[2] = h_lo(x.y) + sigmoid_f(a0[2]) * __uint_as_float(p.y << 16); y0[3] = h_hi(x.y) + sigmoid_f(a0[3]) * __uint_as_float(p.y & 0xffff0000u);
                y1[0] = h_lo(x.z) + sigmoid_f(a1[0]) * __uint_as_float(p.z << 16); y1[1] = h_hi(x.z) + sigmoid_f(a1[1]) * __uint_as_float(p.z & 0xffff0000u);
                y1[2] = h_lo(x.w) + sigmoid_f(a1[2]) * __uint_as_float(p.w << 16); y1[3] = h_hi(x.w) + sigmoid_f(a1[3]) * __uint_as_float(p.w & 0xffff0000u);
                if (Of) { *(f32x4*)(Of + off) = y0; *(f32x4*)(Of + off + 4) = y1; }
                else { u32x4 w; w.x = pkh2(y0[0], y0[1]); w.y = pkh2(y0[2], y0[3]); w.z = pkh2(y1[0], y1[1]); w.w = pkh2(y1[2], y1[3]); *(u32x4*)(Xo + off) = w; } }
            asm volatile("" ::: "memory");
        }
#undef PLI_LOAD
    }
};
template <class Epi, class Sched, bool ALIGN_EPI = false, bool SP2 = false>
__device__ __forceinline__ void gemm_phase(PG8_LAS unsigned char* lds, const Gemm g, const Sched& S, const Epi& E) {
    int tid_ = threadIdx.x; asm volatile("" : "+v"(tid_));
    const int tid = tid_, wid = __builtin_amdgcn_readfirstlane(tid >> 6), lane = tid & 63, wr = wid >> 2, wc = wid & 3, fr = lane & 15, fq = lane >> 4;
    int K_ = g.K; asm volatile("" : "+s"(K_));
    int lda_ = g.lda; asm volatile("" : "+s"(lda_));
    const int K = K_, nt = K / BK;
    unsigned voffA[2], voffB[2];
#pragma unroll
    for (int i = 0; i < 2; ++i) { int R, C; stage_rc(tid * 16 + i * 8192, R, C); const int Rb = Epi::PERM ? ((R & ~31) + perm32(R & 31)) : R;
        voffA[i] = (unsigned)(R * lda_ + C) * 2u; voffB[i] = (unsigned)(Rb * K + C) * 2u; }
    const size_t kstep = (size_t)(BK * 2);
    const size_t hstep = (size_t)HALF * K * 2, hstepA = (size_t)HALF * lda_ * 2;
    const size_t tstep = 2 * hstep, tstepA = 2 * hstepA;
    const unsigned ldsw = (unsigned)wid * 1024u;
    const int aoff = lds_byte(wr * 64 + fr, fq * 8), boff = lds_byte(wc * 32 + fr, fq * 8);
#define PG8_SA(b, h) (((b) * 2 + (h)) * HTB)
#define PG8_SB(b, h) ((4 + (b) * 2 + (h)) * HTB)
#define PG8_STAGE(bufoff, gbase, voff) do { _Pragma("unroll") for (int _i = 0; _i < 2; ++_i) \
        __builtin_amdgcn_global_load_lds((const unsigned*)((const char*)(gbase) + (voff)[_i]), (PG8_LAS unsigned*)(lds + (bufoff) + ldsw + _i * 8192), 16, 0, 0); } while (0)
#define PG8_LDA(dst, b, h) do { _Pragma("unroll") for (int m = 0; m < 4; ++m) _Pragma("unroll") for (int k = 0; k < 2; ++k) dst[m][k] = *(const PG8_LAS bf16x8*)(lds + PG8_SA(b, h) + aoff + m * 2048 + k * 1024); } while (0)
#define PG8_LDB(dst, b, h) do { _Pragma("unroll") for (int n = 0; n < 2; ++n) _Pragma("unroll") for (int k = 0; k < 2; ++k) dst[n][k] = *(const PG8_LAS bf16x8*)(lds + PG8_SB(b, h) + boff + n * 2048 + k * 1024); } while (0)
#define PG8_MMA(ai, bj, At, Bt) do { __builtin_amdgcn_s_setprio(1); _Pragma("unroll") for (int m = 0; m < 4; ++m) _Pragma("unroll") for (int n = 0; n < 2; ++n) _Pragma("unroll") for (int k = 0; k < 2; ++k) \
        acc[ai][bj][m][n] = __builtin_amdgcn_mfma_f32_16x16x32_bf16(Bt[n][k], At[m][k], acc[ai][bj][m][n], 0, 0, 0); __builtin_amdgcn_s_setprio(0); } while (0)
#define PG8_WAIT_V(n) asm volatile("s_waitcnt vmcnt(" #n ")" ::: "memory")
#define PG8_WAIT_L(n) asm volatile("s_waitcnt lgkmcnt(" #n ")" ::: "memory")
#define PG8_BAR __builtin_amdgcn_s_barrier()
#define PG8_SCHED __builtin_amdgcn_sched_barrier(0)
    Unit cur, nxt; int ui = 0;
    if (!S.next(0, cur)) return;
    f32x4 acc[2][2][4][2];
#pragma unroll
    for (int a = 0; a < 2; ++a)
#pragma unroll
        for (int b = 0; b < 2; ++b)
#pragma unroll
            for (int m = 0; m < 4; ++m)
#pragma unroll
                for (int n = 0; n < 2; ++n) acc[a][b][m][n] = (f32x4){0.f, 0.f, 0.f, 0.f};
    bf16x8 At[4][2], B0[2][2], B1[2][2];
    const char* cA = (const char*)g.A + (size_t)cur.pm * tstepA; const char* cB = (const char*)g.Bt + (size_t)cur.pn * tstep;
    S.a_ready(cur);
    if constexpr (SP2) {
        PG8_STAGE(PG8_SB(0, 0), cB, voffB); PG8_STAGE(PG8_SB(0, 1), cB + hstep, voffB); PG8_STAGE(PG8_SA(0, 0), cA, voffA); PG8_STAGE(PG8_SA(0, 1), cA + hstepA, voffA);
        if (wr == 1) PG8_BAR;
        PG8_WAIT_V(2); PG8_BAR;
        PG8_STAGE(PG8_SB(1, 0), cB + kstep, voffB); PG8_STAGE(PG8_SA(1, 0), cA + kstep, voffA); PG8_STAGE(PG8_SB(1, 1), cB + hstep + kstep, voffB);
        PG8_WAIT_V(6); PG8_BAR;
    } else {
        PG8_STAGE(PG8_SB(0, 0), cB, voffB); PG8_STAGE(PG8_SA(0, 0), cA, voffA); PG8_STAGE(PG8_SB(0, 1), cB + hstep, voffB); PG8_STAGE(PG8_SA(0, 1), cA + hstepA, voffA);
        if (wr == 1) PG8_BAR;
        PG8_WAIT_V(4); PG8_BAR;
        PG8_STAGE(PG8_SB(1, 0), cB + kstep, voffB); PG8_STAGE(PG8_SA(1, 0), cA + kstep, voffA); PG8_STAGE(PG8_SB(1, 1), cB + hstep + kstep, voffB);
        PG8_WAIT_V(6); PG8_BAR;
    }
    for (;;) {
        const bool has_next = S.next(ui + 1, nxt);
        const char* nA = has_next ? (const char*)g.A + (size_t)nxt.pm * tstepA : cA; const char* nB = has_next ? (const char*)g.Bt + (size_t)nxt.pn * tstep : cB;
        _Pragma("unroll 1") for (int t = 0; t < nt; t += 2) {
            const bool last = (t == nt - 2);
            const char* a1 = cA + (size_t)(t + 1) * kstep;
            const char* a2 = last ? nA : cA + (size_t)(t + 2) * kstep; const char* b2 = last ? nB : cB + (size_t)(t + 2) * kstep;
            const char* a3 = a2 + kstep; const char* b3 = b2 + kstep;
            if (last && has_next) S.a_ready(nxt);
            if constexpr (SP2) {
            PG8_LDB(B0, 0, 0); PG8_LDB(B1, 0, 1); PG8_SCHED; PG8_LDA(At, 0, 0); PG8_STAGE(PG8_SA(1, 1), a1 + hstepA, voffA);
            PG8_WAIT_V(8); PG8_WAIT_L(0); PG8_BAR; PG8_MMA(0, 0, At, B0); PG8_MMA(0, 1, At, B1); PG8_BAR; PG8_SCHED;
            PG8_LDA(At, 0, 1); PG8_STAGE(PG8_SB(0, 0), b2, voffB); PG8_STAGE(PG8_SB(0, 1), b2 + hstep, voffB); PG8_STAGE(PG8_SA(0, 0), a2, voffA);
            PG8_WAIT_V(8); PG8_WAIT_L(0); PG8_BAR; PG8_MMA(1, 0, At, B0); PG8_MMA(1, 1, At, B1); PG8_BAR; PG8_SCHED;
            PG8_LDB(B0, 1, 0); PG8_LDB(B1, 1, 1); PG8_SCHED; PG8_LDA(At, 1, 0); PG8_STAGE(PG8_SA(0, 1), a2 + hstepA, voffA);
            PG8_WAIT_V(8); PG8_WAIT_L(0); PG8_BAR; PG8_MMA(0, 0, At, B0); PG8_MMA(0, 1, At, B1); PG8_BAR; PG8_SCHED;
            PG8_LDA(At, 1, 1); PG8_STAGE(PG8_SB(1, 0), b3, voffB); PG8_STAGE(PG8_SB(1, 1), b3 + hstep, voffB); PG8_STAGE(PG8_SA(1, 0), a3, voffA);
            PG8_WAIT_V(8); PG8_WAIT_L(0); PG8_BAR; PG8_MMA(1, 0, At, B0); PG8_MMA(1, 1, At, B1); PG8_BAR; PG8_SCHED;
            } else {
            PG8_LDB(B0, 0, 0); PG8_SCHED; PG8_LDA(At, 0, 0); PG8_STAGE(PG8_SA(1, 1), a1 + hstepA, voffA);
            PG8_WAIT_L(8); PG8_BAR; PG8_WAIT_L(0); PG8_MMA(0, 0, At, B0); PG8_BAR; PG8_SCHED;
            PG8_LDB(B1, 0, 1); PG8_STAGE(PG8_SB(0, 0), b2, voffB);
            PG8_BAR; PG8_WAIT_L(0); PG8_MMA(0, 1, At, B1); PG8_BAR;
            PG8_LDA(At, 0, 1); PG8_STAGE(PG8_SA(0, 0), a2, voffA);
            PG8_BAR; PG8_WAIT_L(0); PG8_MMA(1, 0, At, B0); PG8_BAR; PG8_SCHED;
            PG8_STAGE(PG8_SB(0, 1), b2 + hstep, voffB);
            PG8_WAIT_V(6); PG8_BAR; PG8_MMA(1, 1, At, B1); PG8_BAR;
            PG8_LDB(B0, 1, 0); PG8_SCHED; PG8_LDA(At, 1, 0); PG8_STAGE(PG8_SA(0, 1), a2 + hstepA, voffA);
            PG8_WAIT_L(8); PG8_BAR; PG8_WAIT_L(0); PG8_MMA(0, 0, At, B0); PG8_BAR; PG8_SCHED;
            PG8_LDB(B1, 1, 1); PG8_STAGE(PG8_SB(1, 0), b3, voffB);
            PG8_BAR; PG8_WAIT_L(0); PG8_MMA(0, 1, At, B1); PG8_BAR;
            PG8_LDA(At, 1, 1); PG8_STAGE(PG8_SA(1, 0), a3, voffA);
            PG8_BAR; PG8_WAIT_L(0); PG8_MMA(1, 0, At, B0); PG8_BAR; PG8_SCHED;
            PG8_STAGE(PG8_SB(1, 1), b3 + hstep, voffB);
            PG8_WAIT_V(6); PG8_BAR; PG8_MMA(1, 1, At, B1); PG8_BAR;
            }
        }
        if constexpr (ALIGN_EPI) { if (wr == 0) PG8_BAR; }
        if constexpr (!Epi::AFTER_DRAIN) { E(acc, cur, wr, wc, fr, fq); S.done(cur); }
        if (!has_next) break;
#pragma unroll
        for (int a = 0; a < 2; ++a)
#pragma unroll
            for (int b = 0; b < 2; ++b)
#pragma unroll
                for (int m = 0; m < 4; ++m)
#pragma unroll
                    for (int n = 0; n < 2; ++n) acc[a][b][m][n] = (f32x4){0.f, 0.f, 0.f, 0.f};
        cur = nxt; cA = nA; cB = nB; ++ui;
        if constexpr (ALIGN_EPI) { if (wr == 1) PG8_BAR; }
    }
    PG8_WAIT_V(0);
    if constexpr (!ALIGN_EPI) { if (wr == 0) PG8_BAR; }
    PG8_BAR;
    if constexpr (Epi::AFTER_DRAIN) { E.fused(acc, cur, wr, wc, fr, fq, lds, wid, lane); S.done(cur); }
#undef PG8_SA
#undef PG8_SB
#undef PG8_STAGE
#undef PG8_LDA
#undef PG8_LDB
#undef PG8_MMA
#undef PG8_WAIT_V
#undef PG8_WAIT_L
#undef PG8_BAR
#undef PG8_SCHED
}
}
#define GAS __attribute__((address_space(1)))
#define LAS __attribute__((address_space(3)))
typedef unsigned short bf16;
typedef unsigned v4u __attribute__((ext_vector_type(4)));
typedef float f32x4 __attribute__((ext_vector_type(4)));
typedef short bf16x8 __attribute__((ext_vector_type(8)));
typedef GAS unsigned gu32;
typedef GAS unsigned long long gu64;
#define RLX_AGENT __ATOMIC_RELAXED, __HIP_MEMORY_SCOPE_AGENT
#define LDS_WAIT() asm volatile("s_waitcnt lgkmcnt(0)" ::: "memory")
#define VM_WAIT() asm volatile("s_waitcnt vmcnt(0)" ::: "memory")
__device__ __forceinline__ unsigned long long rt() { return __builtin_amdgcn_s_memrealtime(); }
__device__ __forceinline__ unsigned f2bf(float f) { unsigned u = __builtin_bit_cast(unsigned, f); return (u + 0x7fffu + ((u >> 16) & 1u)) >> 16; }
__device__ __forceinline__ unsigned pk2(float lo, float hi) { return f2bf(lo) | (f2bf(hi) << 16); }

#define XB_TMO      128
#define XB_XCNT(j)  (256  + 64 * (j))
#define XB_XSUB(j)  (1280 + 64 * (j))
#define XB_XGEN(j)  (2304 + 64 * (j))
#define XB_TOP      3328
#define XB_TOPGEN   3392
#define XCD_BAR_WORDS 3456
#define XB_SPIN_CAP (1u << 18)

__device__ __forceinline__ unsigned xb_ld(unsigned* p)              { return __hip_atomic_load(p, __ATOMIC_RELAXED, __HIP_MEMORY_SCOPE_AGENT); }
__device__ __forceinline__ unsigned xb_add(unsigned* p, unsigned v) { return __hip_atomic_fetch_add(p, v, __ATOMIC_RELAXED, __HIP_MEMORY_SCOPE_AGENT); }
__device__ __forceinline__ unsigned xb_xcc_id() { return (unsigned)__builtin_amdgcn_s_getreg((3 << 11) | 20) & 0xFu; }
#define XB_SPIN(cond, bar) do { unsigned _sp = 0; while (cond) { __builtin_amdgcn_s_sleep(1); \
    if ((++_sp & 255u) == 0u) { if (xb_ld(&(bar)[XB_TMO])) break; if (_sp > XB_SPIN_CAP) { atomicAdd(&(bar)[XB_TMO], 1u); break; } } } } while (0)

struct XcdBarrier {
    unsigned* bar; unsigned x;
    volatile LAS unsigned* st;
};

__device__ __forceinline__ XcdBarrier xcd_barrier_post(unsigned* bar, volatile LAS unsigned* st) {
    XcdBarrier b; b.bar = bar; b.x = xb_xcc_id(); b.st = st;
    if (threadIdx.x == 0) (void)xb_add(&bar[XB_XCNT(b.x)], 1u);
    return b;
}
__device__ __forceinline__ void xcd_barrier_complete(unsigned* bar, unsigned x, unsigned& nloc, unsigned& nx) {
    const unsigned G = gridDim.x * gridDim.y * gridDim.z;
    unsigned sum, cnt, mine, sp = 0u;
    for (;;) {
        sum = 0u; cnt = 0u; mine = 0u;
#pragma unroll
        for (unsigned j = 0; j < 16; ++j) { const unsigned c = xb_ld(&bar[XB_XCNT(j)]); sum += c; cnt += (c > 0u) ? 1u : 0u; mine = (j == x) ? c : mine; }
        if (sum == G) break;
        __builtin_amdgcn_s_sleep(1);
        if ((++sp & 255u) == 0u) { if (xb_ld(&bar[XB_TMO])) break; if (sp > XB_SPIN_CAP) { atomicAdd(&bar[XB_TMO], 1u); break; } }
    }
    nloc = mine > 0u ? mine : 1u; nx = cnt > 0u ? cnt : 1u;
}

__device__ __forceinline__ void xcd_barrier(const XcdBarrier& b) {
    asm volatile("s_waitcnt vmcnt(0)" ::: "memory");
    __syncthreads();
    if (threadIdx.x == 0) {
        unsigned* bar = b.bar;
        __builtin_amdgcn_s_waitcnt(0);
        unsigned nloc = b.st[0], nx = b.st[1];
        if (nloc == 0u) { xcd_barrier_complete(bar, b.x, nloc, nx); b.st[0] = nloc; b.st[1] = nx; }
        const unsigned old = xb_add(&bar[XB_XSUB(b.x)], 1u);
        const unsigned gen = old / nloc;
        if (old + 1u == (gen + 1u) * nloc) {
            __builtin_amdgcn_fence(__ATOMIC_RELEASE, "agent");
            asm volatile("s_waitcnt vmcnt(0)" ::: "memory");
            const unsigned og = xb_add(&bar[XB_TOP], 1u);
            const unsigned tg = og / nx;
            if (og + 1u == (tg + 1u) * nx) xb_add(&bar[XB_TOPGEN], 1u);
            else XB_SPIN(xb_ld(&bar[XB_TOPGEN]) == tg, bar);
            __builtin_amdgcn_fence(__ATOMIC_ACQUIRE, "agent");
            xb_add(&bar[XB_XGEN(b.x)], 1u);
            asm volatile("s_waitcnt vmcnt(0)" ::: "memory");
        } else {
            XB_SPIN(xb_ld(&bar[XB_XGEN(b.x)]) == gen, bar);
            __builtin_amdgcn_fence(__ATOMIC_ACQUIRE, "agent");
            asm volatile("s_waitcnt vmcnt(0)" ::: "memory");
        }
    }
    __syncthreads();
}

constexpr int NWAVES = 8;
constexpr int BATCH = 8, SEQ = 4096, DM = 2048, DEPTH = 4, HD = 128, NHS = 8, NHD = 8, INW = 6144, DFF = 5632, PLI = 256;
constexpr int PJP = INW + 128;
constexpr int M = BATCH * SEQ;
constexpr float RMS_EPS = 1e-6f;
constexpr float QK_SCALE = 0.08838834764831845f;
constexpr float LOG2E = 1.4426950408889634f;
#ifndef MK_N_LAUNCHES
#define MK_N_LAUNCHES 1
#endif
constexpr int PH_PER_LAYER = 10, N_PHASES = 1 + DEPTH * PH_PER_LAYER;
constexpr size_t MiB = 1u << 20;
constexpr size_t WS_CTL = 0, CTL_ZERO_BYTES = 1 * MiB;
constexpr size_t WS_W = 1 * MiB, W_LAYER = 107 * MiB;
constexpr size_t WO_IN = 0, WO_OUT = 24 * MiB, WO_GU = 32 * MiB, WO_DN = 76 * MiB, WO_PG = 98 * MiB, WO_PP = 106 * MiB;
constexpr size_t WS_H = 432 * MiB;
constexpr size_t WS_PROJ = 560 * MiB;
constexpr size_t WS_O = 952 * MiB;
constexpr size_t WS_Y = 1080 * MiB;
constexpr size_t WS_P16 = 1208 * MiB;
constexpr size_t WS_DLP = WS_Y;
constexpr size_t WS_XH = 1224 * MiB;
constexpr size_t WS_LSE = 1352 * MiB;
constexpr size_t WS_END = 1354 * MiB;
static_assert(WS_PROJ + (size_t)M * PJP * 2 <= WS_O && WS_PROJ + (size_t)M * DFF * 2 <= WS_O, "PROJ / ACT overlay fits below O");
constexpr int CW_TMO = 0, CW_CODE = 1, CW_BAR = 4096, CW_GRP = 8192;
constexpr int RING_OFF = 0, RING_BYTES = 131072;
constexpr int LDSCTL_OFF = RING_BYTES, MISC_OFF = LDSCTL_OFF + 320;
constexpr int TAB_OFF = RING_BYTES + 1024;
constexpr int VOTE_OFF = TAB_OFF + 20480;
constexpr int LDS_BYTES = 155648;

struct Frame {
    LAS unsigned char* lds;
    volatile LAS unsigned* MISC;
    gu32* ctl;
    int wave;
    int vcu, G;
};
struct Args { const float* in[15]; float* out; unsigned char* ws; int ph_lo, ph_hi, li, pad; };

__device__ __forceinline__ float xor_lane(float v, int mask, int lane) { return __int_as_float(__builtin_amdgcn_ds_bpermute((lane ^ mask) << 2, __float_as_int(v))); }
__device__ __forceinline__ float wave_sum(float v, int lane) {
#pragma unroll
    for (int o = 1; o < 64; o <<= 1) v += xor_lane(v, o, lane);
    return v;
}
__device__ __forceinline__ int opaque_v(int x) { asm volatile("" : "+v"(x)); return x; }
__device__ __forceinline__ int lane_now() { return opaque_v((int)__builtin_amdgcn_mbcnt_hi(~0u, __builtin_amdgcn_mbcnt_lo(~0u, 0u))); }
__device__ __forceinline__ float bf_lo(unsigned u) { return __uint_as_float(u << 16); }
__device__ __forceinline__ float bf_hi(unsigned u) { return __uint_as_float(u & 0xffff0000u); }

__device__ __forceinline__ void p0_transpose_item(const float* W, int K, int N, bf16* WT, int k0, int n0, int dst_row0, LAS float* scr, int lane) {
#pragma unroll 8
    for (int i = 0; i < 32; ++i) { const int kk = 2 * i + (lane >> 5); scr[kk * 33 + (lane & 31)] = W[(size_t)(k0 + kk) * N + n0 + (lane & 31)]; }
    LDS_WAIT(); asm volatile("" ::: "memory");
    const int c = lane & 7;
#pragma unroll
    for (int j = 0; j < 4; ++j) { const int n = (lane >> 3) + 8 * j; const LAS float* s = scr + (8 * c) * 33 + n;
        v4u o; o.x = pk2(s[0 * 33], s[1 * 33]); o.y = pk2(s[2 * 33], s[3 * 33]); o.z = pk2(s[4 * 33], s[5 * 33]); o.w = pk2(s[6 * 33], s[7 * 33]);
        *(GAS v4u*)(WT + (size_t)(dst_row0 + n) * K + k0 + 8 * c) = o; }
    LDS_WAIT(); asm volatile("" ::: "memory");
}
__device__ __forceinline__ void convert_weights(Frame& F, const Args& a) {
    LAS float* scr = (LAS float*)(F.lds + RING_OFF + F.wave * 16384);
    const int gw = F.vcu * NWAVES + F.wave, NGW = F.G * NWAVES, lane = lane_now();
    constexpr int I_IN = (DM / 64) * (INW / 32), I_OUT = (DM / 64) * (DM / 32), I_GU = (DM / 64) * (2 * DFF / 32), I_DN = (DFF / 64) * (DM / 32), I_PG = I_OUT, I_PP = (PLI / 64) * (DM / 32);
    constexpr int I_LAYER = I_IN + I_OUT + I_GU + I_DN + I_PG + I_PP;
    for (int it = gw; it < DEPTH * I_LAYER; it += NGW) {
        const int L = it / I_LAYER; int r = it % I_LAYER;
        unsigned char* wl = a.ws + WS_W + (size_t)L * W_LAYER;
        const float* W; int K, N; bf16* WT; bool gu = false;
        if (r < I_IN) { W = a.in[3] + (size_t)L * DM * INW; K = DM; N = INW; WT = (bf16*)(wl + WO_IN); }
        else if ((r -= I_IN) < I_OUT) { W = a.in[5] + (size_t)L * DM * DM; K = DM; N = DM; WT = (bf16*)(wl + WO_OUT); }
        else if ((r -= I_OUT) < I_GU) { W = a.in[9] + (size_t)L * DM * 2 * DFF; K = DM; N = 2 * DFF; WT = (bf16*)(wl + WO_GU); gu = true; }
        else if ((r -= I_GU) < I_DN) { W = a.in[10] + (size_t)L * DFF * DM; K = DFF; N = DM; WT = (bf16*)(wl + WO_DN); }
        else if ((r -= I_DN) < I_PG) { W = a.in[13] + (size_t)L * DM * DM; K = DM; N = DM; WT = (bf16*)(wl + WO_PG); }
        else { r -= I_PG; W = a.in[14] + (size_t)L * PLI * DM; K = PLI; N = DM; WT = (bf16*)(wl + WO_PP); }
        const int nblk = N / 32, kb = r / nblk, nb = r % nblk, k0 = 64 * kb, n0 = 32 * nb;
        int d0 = n0;
        if (gu) { d0 = (n0 < DFF) ? 256 * (n0 / 128) + (n0 % 128) : 256 * ((n0 - DFF) / 128) + 128 + ((n0 - DFF) % 128); }
        p0_transpose_item(W, K, N, WT, k0, n0, d0, scr, lane);
    }
}
struct Row32 { float v[4][8]; };
__device__ __forceinline__ void load_f32_row(const float* p, int lane, Row32& r) {
#pragma unroll
    for (int j = 0; j < 4; ++j) { const f32x4 a = *(const GAS f32x4*)(p + 512 * j + 8 * lane), b = *(const GAS f32x4*)(p + 512 * j + 8 * lane + 4);
        r.v[j][0] = a[0]; r.v[j][1] = a[1]; r.v[j][2] = a[2]; r.v[j][3] = a[3]; r.v[j][4] = b[0]; r.v[j][5] = b[1]; r.v[j][6] = b[2]; r.v[j][7] = b[3]; }
}
__device__ __forceinline__ void store_f32_row(float* p, int lane, const Row32& r) {
#pragma unroll
    for (int j = 0; j < 4; ++j) { f32x4 a, b; a[0] = r.v[j][0]; a[1] = r.v[j][1]; a[2] = r.v[j][2]; a[3] = r.v[j][3]; b[0] = r.v[j][4]; b[1] = r.v[j][5]; b[2] = r.v[j][6]; b[3] = r.v[j][7];
        *(GAS f32x4*)(p + 512 * j + 8 * lane) = a; *(GAS f32x4*)(p + 512 * j + 8 * lane + 4) = b; }
}
__device__ __forceinline__ void load_bf16_row(const bf16* p, int lane, Row32& r) {
#pragma unroll
    for (int j = 0; j < 4; ++j) { const v4u a = *(const GAS v4u*)(p + 512 * j + 8 * lane);
        r.v[j][0] = bf_lo(a.x); r.v[j][1] = bf_hi(a.x); r.v[j][2] = bf_lo(a.y); r.v[j][3] = bf_hi(a.y); r.v[j][4] = bf_lo(a.z); r.v[j][5] = bf_hi(a.z); r.v[j][6] = bf_lo(a.w); r.v[j][7] = bf_hi(a.w); }
}
__device__ __forceinline__ float row_sumsq(const Row32& r, int lane) {
    float s = 0.f;
#pragma unroll
    for (int j = 0; j < 4; ++j)
#pragma unroll
        for (int e = 0; e < 8; ++e) s += r.v[j][e] * r.v[j][e];
    return wave_sum(s, lane);
}
__device__ __forceinline__ void store_norm_bf16(bf16* p, int lane, const Row32& x, float rstd, const Row32& g) {
#pragma unroll
    for (int j = 0; j < 4; ++j) { v4u o;
        o.x = pk2(x.v[j][0] * rstd * g.v[j][0], x.v[j][1] * rstd * g.v[j][1]); o.y = pk2(x.v[j][2] * rstd * g.v[j][2], x.v[j][3] * rstd * g.v[j][3]);
        o.z = pk2(x.v[j][4] * rstd * g.v[j][4], x.v[j][5] * rstd * g.v[j][5]); o.w = pk2(x.v[j][6] * rstd * g.v[j][6], x.v[j][7] * rstd * g.v[j][7]);
        *(GAS v4u*)(p + 512 * j + 8 * lane) = o; }
}
__device__ __forceinline__ void load_h16_row(const unsigned short* p, int lane, Row32& r) {
#pragma unroll
    for (int j = 0; j < 4; ++j) { const v4u a = *(const GAS v4u*)(p + 512 * j + 8 * lane);
        r.v[j][0] = pg8::h_lo(a.x); r.v[j][1] = pg8::h_hi(a.x); r.v[j][2] = pg8::h_lo(a.y); r.v[j][3] = pg8::h_hi(a.y); r.v[j][4] = pg8::h_lo(a.z); r.v[j][5] = pg8::h_hi(a.z); r.v[j][6] = pg8::h_lo(a.w); r.v[j][7] = pg8::h_hi(a.w); }
}
__device__ __forceinline__ void store_h16_row(unsigned short* p, int lane, const Row32& r) {
#pragma unroll
    for (int j = 0; j < 4; ++j) { v4u o; o.x = pg8::pkh2(r.v[j][0], r.v[j][1]); o.y = pg8::pkh2(r.v[j][2], r.v[j][3]); o.z = pg8::pkh2(r.v[j][4], r.v[j][5]); o.w = pg8::pkh2(r.v[j][6], r.v[j][7]);
        *(GAS v4u*)(p + 512 * j + 8 * lane) = o; }
}
__device__ __forceinline__ void norm_only_phase(Frame& F, const float* xs32, const unsigned short* xsh, const float* gain, bf16* H) {
    const int gw = F.vcu * NWAVES + F.wave, NGW = F.G * NWAVES, lane = lane_now();
    Row32 g; load_f32_row(gain, lane, g);
    for (int m = gw; m < M; m += NGW) {
        Row32 x; if (xs32) load_f32_row(xs32 + (size_t)m * DM, lane, x); else load_h16_row(xsh + (size_t)m * DM, lane, x);
        const float rstd = rsqrtf(row_sumsq(x, lane) * (1.f / DM) + RMS_EPS);
        store_norm_bf16(H + (size_t)m * DM, lane, x, rstd, g);
    }
}
__device__ __forceinline__ void resid_norm_phase(Frame& F, const float* xs32, const unsigned short* xsh, unsigned short* xdh, const bf16* Y, const float* gain1, const float* gain2, bf16* H, const float* prow, bf16* P16) {
    const int gw = F.vcu * NWAVES + F.wave, NGW = F.G * NWAVES, lane = lane_now();
    Row32 g1, g2; load_f32_row(gain1, lane, g1); load_f32_row(gain2, lane, g2);
    for (int m = gw; m < M; m += NGW) {
        Row32 y, x; load_bf16_row(Y + (size_t)m * DM, lane, y);
        if (xs32) load_f32_row(xs32 + (size_t)m * DM, lane, x); else load_h16_row(xsh + (size_t)m * DM, lane, x);
        const float r1 = rsqrtf(row_sumsq(y, lane) * (1.f / DM) + RMS_EPS);
#pragma unroll
        for (int j = 0; j < 4; ++j)
#pragma unroll
            for (int e = 0; e < 8; ++e) x.v[j][e] += y.v[j][e] * r1 * g1.v[j][e];
        store_h16_row(xdh + (size_t)m * DM, lane, x);
        const float r2 = rsqrtf(row_sumsq(x, lane) * (1.f / DM) + RMS_EPS);
        store_norm_bf16(H + (size_t)m * DM, lane, x, r2, g2);
        if (prow) { const f32x4 pv = *(const GAS f32x4*)(prow + (size_t)m * PLI + 4 * lane);
            unsigned long long w = (unsigned long long)pk2(pv[0], pv[1]) | ((unsigned long long)pk2(pv[2], pv[3]) << 32);
            *(GAS unsigned long long*)(P16 + (size_t)m * PLI + 4 * lane) = w; }
    }
}
__device__ __forceinline__ int t5_bucket(int dist) {
    if (dist < 16) return dist;
    const float v = logf((float)dist * (1.f / 16.f)) / 4.852030263919617f * 16.f;
    const int large = 16 + (int)v; return large < 31 ? large : 31;
}
namespace fa {
typedef __bf16 bf16x8_t __attribute__((ext_vector_type(8)));
typedef float f32x8 __attribute__((ext_vector_type(8)));
typedef short s16x8 __attribute__((ext_vector_type(8)));
typedef short s16x4 __attribute__((ext_vector_type(4)));
typedef float f32x16 __attribute__((ext_vector_type(16)));
constexpr float SC2 = QK_SCALE * LOG2E;
constexpr float NEG_BIG = -1e30f;
constexpr float SB_EXIT = -150.f;
constexpr float DEFER = 8.f;
constexpr int TAB_PAD = 32, TAB_STRIDE = 200;

__device__ __forceinline__ unsigned off_b(unsigned row, unsigned ch) { return 256u * row + 16u * (ch ^ (((row & 3u) << 2) | ((row >> 2) & 3u))); }
#define FA_WAIT_V(n) asm volatile("s_waitcnt vmcnt(" #n ")" ::: "memory")
__device__ __forceinline__ void load_q(s16x8 (&qf)[8], const bf16* qrow, int lane) {
#pragma unroll
    for (int s = 0; s < 8; ++s) qf[s] = *(const GAS s16x8*)(qrow + 16 * s + 8 * (lane >> 5));
}
__device__ __forceinline__ unsigned long long pack4(float a, float b, float c, float d) { return (unsigned long long)pk2(a, b) | ((unsigned long long)pk2(c, d) << 32); }
__device__ __forceinline__ void swap32(unsigned& a, unsigned& b) { const auto r = __builtin_amdgcn_permlane32_swap(a, b, false, false); a = r[0]; b = r[1]; }
typedef unsigned u32x4s __attribute__((ext_vector_type(4)));
__device__ __forceinline__ void store_pair16(bf16* dst, unsigned long long Y, unsigned long long X) {
    unsigned y0 = (unsigned)Y, y1 = (unsigned)(Y >> 32), x0 = (unsigned)X, x1 = (unsigned)(X >> 32);
    swap32(y0, x0); swap32(y1, x1);
    u32x4s w; w.x = y0; w.y = y1; w.z = x0; w.w = x1; *(GAS u32x4s*)dst = w;
}
__device__ __forceinline__ void unswap_pair16(u32x4s w, unsigned long long& Y, unsigned long long& X) {
    unsigned l0 = w.x, l1 = w.y, l2 = w.z, l3 = w.w;
    swap32(l0, l2); swap32(l1, l3);
    Y = (unsigned long long)l0 | ((unsigned long long)l1 << 32); X = (unsigned long long)l2 | ((unsigned long long)l3 << 32);
}
__device__ __forceinline__ void headnorm_store(const f32x16 (&o)[4], bf16* orow, const float* g, int lane_) {
    const int lane = opaque_v(lane_), hh = lane >> 5;
    float ss = 0.f;
#pragma unroll
    for (int db = 0; db < 4; ++db)
#pragma unroll
        for (int i = 0; i < 16; ++i) ss += o[db][i] * o[db][i];
    ss += xor_lane(ss, 32, lane);
    const float rstd = rsqrtf(ss * (1.f / HD) + RMS_EPS);
#pragma unroll
    for (int db = 0; db < 4; ++db)
#pragma unroll
        for (int g2 = 0; g2 < 2; ++g2) { unsigned long long P[2];
#pragma unroll
            for (int q = 0; q < 2; ++q) { const int gq = 2 * g2 + q, d = 32 * db + 8 * gq + 4 * hh; const f32x4 gv = *(const GAS f32x4*)(g + d);
                P[q] = pack4(o[db][4 * gq] * rstd * gv[0], o[db][4 * gq + 1] * rstd * gv[1], o[db][4 * gq + 2] * rstd * gv[2], o[db][4 * gq + 3] * rstd * gv[3]); }
            store_pair16(orow + 32 * db + 16 * g2 + 8 * hh, P[0], P[1]); }
}
template <bool DIAG> __device__ __forceinline__ f32x16 sb_weights(const f32x16& x, float& carry, int qrel, int hh, int lane) {
    float lk[16], zz[16];
#pragma unroll
    for (int i = 0; i < 16; ++i) { const float z2 = x[i] * SC2, e = __builtin_amdgcn_exp2f(-fabsf(z2)), sp = fmaxf(z2, 0.f) + __builtin_amdgcn_logf(1.f + e);
        lk[i] = -sp; zz[i] = z2 - sp;
        if (DIAG) { const bool valid = ((i & 3) + 8 * (i >> 2)) < qrel; lk[i] = valid ? lk[i] : 0.f; zz[i] = valid ? zz[i] : NEG_BIG; } }
    float T[4], To[4];
#pragma unroll
    for (int g = 0; g < 4; ++g) { T[g] = (lk[4 * g] + lk[4 * g + 1]) + (lk[4 * g + 2] + lk[4 * g + 3]); To[g] = xor_lane(T[g], 32, lane); }
    const float pr0 = T[0] + To[0], pr1 = T[1] + To[1], pr2 = T[2] + To[2], pr3 = T[3] + To[3];
    float U[4]; U[3] = 0.f; U[2] = pr3; U[1] = pr3 + pr2; U[0] = U[1] + pr1;
    f32x16 p;
#pragma unroll
    for (int g = 0; g < 4; ++g) { float later = carry + U[g] + (hh == 0 ? To[g] : 0.f);
        p[4 * g + 3] = __builtin_amdgcn_exp2f(zz[4 * g + 3] + later); later += lk[4 * g + 3];
        p[4 * g + 2] = __builtin_amdgcn_exp2f(zz[4 * g + 2] + later); later += lk[4 * g + 2];
        p[4 * g + 1] = __builtin_amdgcn_exp2f(zz[4 * g + 1] + later); later += lk[4 * g + 1];
        p[4 * g + 0] = __builtin_amdgcn_exp2f(zz[4 * g + 0] + later); }
    carry += U[0] + pr0;
    return p;
}
__device__ __forceinline__ void dl_store_partial(const f32x16 (&o)[4], float m, float l, bf16* DLP, float* LSE, int grp, int b, int hd, int P0, int dil, int lane) {
    const int r = lane & 31, hh = lane >> 5; const size_t row = (size_t)b * SEQ + P0 + r * dil;
    bf16* dp = DLP + (size_t)(grp - 1) * M * 1024 + row * 1024 + hd * HD + 8 * hh;
    const float inv = 1.f / l;
#pragma unroll
    for (int db = 0; db < 4; ++db)
#pragma unroll
        for (int g2 = 0; g2 < 2; ++g2)
            store_pair16(dp + 32 * db + 16 * g2, pack4(o[db][8 * g2] * inv, o[db][8 * g2 + 1] * inv, o[db][8 * g2 + 2] * inv, o[db][8 * g2 + 3] * inv),
                         pack4(o[db][8 * g2 + 4] * inv, o[db][8 * g2 + 5] * inv, o[db][8 * g2 + 6] * inv, o[db][8 * g2 + 7] * inv));
    if (hh == 0) *(GAS float*)(LSE + (size_t)(grp - 1) * M * 8 + row * 8 + hd) = m + __builtin_amdgcn_logf(l);
}
__device__ __forceinline__ void dl_combine_store(f32x16 (&o)[4], float m, float l, const bf16* DLP, const float* LSE, bf16* O, const float* ghead, int b, int hd, int P0, int lane) {
    const int r = lane & 31, hh = lane >> 5; const size_t row = (size_t)b * SEQ + P0 + r;
    const float lse0 = m + __builtin_amdgcn_logf(l);
    const float lse1 = *(const GAS float*)(LSE + row * 8 + hd), lse2 = *(const GAS float*)(LSE + (size_t)M * 8 + row * 8 + hd);
    const float mx = fmaxf(lse0, fmaxf(lse1, lse2));
    const float e0 = __builtin_amdgcn_exp2f(lse0 - mx), w1 = __builtin_amdgcn_exp2f(lse1 - mx), w2 = __builtin_amdgcn_exp2f(lse2 - mx);
    const float invW = 1.f / (e0 + w1 + w2), w0 = e0 / l;
    const bf16* p1 = DLP + row * 1024 + hd * HD + 8 * hh; const bf16* p2 = p1 + (size_t)M * 1024;
    u32x4s la[4][2], lc[4][2];
#pragma unroll
    for (int db = 0; db < 4; ++db)
#pragma unroll
        for (int g2 = 0; g2 < 2; ++g2) { la[db][g2] = *(const GAS u32x4s*)(p1 + 32 * db + 16 * g2); lc[db][g2] = *(const GAS u32x4s*)(p2 + 32 * db + 16 * g2); }
    unsigned long long a[4][4], c[4][4];
#pragma unroll
    for (int db = 0; db < 4; ++db)
#pragma unroll
        for (int g2 = 0; g2 < 2; ++g2) { unswap_pair16(la[db][g2], a[db][2 * g2], a[db][2 * g2 + 1]); unswap_pair16(lc[db][g2], c[db][2 * g2], c[db][2 * g2 + 1]); }
#pragma unroll
    for (int db = 0; db < 4; ++db)
#pragma unroll
        for (int gq = 0; gq < 4; ++gq) { const unsigned a0 = (unsigned)a[db][gq], a1 = (unsigned)(a[db][gq] >> 32), c0 = (unsigned)c[db][gq], c1 = (unsigned)(c[db][gq] >> 32);
            o[db][4 * gq]     = (o[db][4 * gq]     * w0 + bf_lo(a0) * w1 + bf_lo(c0) * w2) * invW;
            o[db][4 * gq + 1] = (o[db][4 * gq + 1] * w0 + bf_hi(a0) * w1 + bf_hi(c0) * w2) * invW;
            o[db][4 * gq + 2] = (o[db][4 * gq + 2] * w0 + bf_lo(a1) * w1 + bf_lo(c1) * w2) * invW;
            o[db][4 * gq + 3] = (o[db][4 * gq + 3] * w0 + bf_hi(a1) * w1 + bf_hi(c1) * w2) * invW; }
    headnorm_store(o, O + row * DM + 1024 + hd * HD, ghead + 1024 + hd * HD, lane);
}
}
namespace fb {
using fa::s16x8; using fa::s16x4; using fa::f32x16; using fa::f32x8; using fa::bf16x8_t; using fa::off_b; using fa::SC2; using fa::NEG_BIG; using fa::SB_EXIT; using fa::DEFER; using fa::TAB_PAD; using fa::TAB_STRIDE;
struct TAddr { unsigned kR, kX, vR, vY, vQ, dma[2]; };
__device__ __forceinline__ void team_addr(TAddr& A, LAS unsigned char* ring, int i, int dil, int lane) {
    const unsigned kb = (unsigned)(size_t)ring;
    const unsigned r = lane & 31, h = lane >> 5, blk = (lane >> 4) & 1, q = (lane & 15) >> 2, pp = lane & 3;
    A.kR = kb + 256u * r; A.kX = h ^ (((r & 3u) << 2) | ((r >> 2) & 3u));
    A.vR = kb + 8192u + 256u * (4 * h + q) + 8u * (pp & 1); A.vY = (2 * blk + (pp >> 1)) ^ h; A.vQ = q;
#pragma unroll
    for (int qq = 0; qq < 2; ++qq) { const unsigned p = 2 * i + qq, row = 4 * p + (lane >> 4), ch = (lane & 15) ^ ((((lane >> 4) & 3) << 2) | (p & 3));
        A.dma[qq] = (row * (unsigned)dil * PJP + ch * 8) * 2u; }
}
__device__ __forceinline__ void team_issue(LAS unsigned char* slot, int i, const char* kb0, const TAddr& A) {
#pragma unroll
    for (int qq = 0; qq < 2; ++qq) {
        __builtin_amdgcn_global_load_lds((const unsigned*)(kb0 + A.dma[qq]), (LAS unsigned*)(slot + 1024 * (2 * i + qq)), 16, 0, 0);
        __builtin_amdgcn_global_load_lds((const unsigned*)(kb0 + 2048 + A.dma[qq]), (LAS unsigned*)(slot + 8192 + 1024 * (2 * i + qq)), 16, 0, 0); }
}
__device__ __forceinline__ f32x16 qk_slot(const TAddr& A, unsigned so, const s16x8 (&qf)[8]) {
    s16x8 k0, k1, k2, k3, k4, k5, k6, k7;
    const unsigned R = A.kR + so, X = A.kX;
    asm volatile("ds_read_b128 %0, %8\n\tds_read_b128 %1, %9\n\tds_read_b128 %2, %10\n\tds_read_b128 %3, %11\n\tds_read_b128 %4, %12\n\tds_read_b128 %5, %13\n\tds_read_b128 %6, %14\n\tds_read_b128 %7, %15\n\ts_waitcnt lgkmcnt(0)"
                 : "=&v"(k0), "=&v"(k1), "=&v"(k2), "=&v"(k3), "=&v"(k4), "=&v"(k5), "=&v"(k6), "=&v"(k7)
                 : "v"(R + ((0u ^ X) << 4)), "v"(R + ((2u ^ X) << 4)), "v"(R + ((4u ^ X) << 4)), "v"(R + ((6u ^ X) << 4)), "v"(R + ((8u ^ X) << 4)), "v"(R + ((10u ^ X) << 4)), "v"(R + ((12u ^ X) << 4)), "v"(R + ((14u ^ X) << 4)) : "memory");
    f32x16 x;
#pragma unroll
    for (int e = 0; e < 16; ++e) x[e] = 0.f;
    x = __builtin_amdgcn_mfma_f32_32x32x16_bf16(k0, qf[0], x, 0, 0, 0); x = __builtin_amdgcn_mfma_f32_32x32x16_bf16(k1, qf[1], x, 0, 0, 0);
    x = __builtin_amdgcn_mfma_f32_32x32x16_bf16(k2, qf[2], x, 0, 0, 0); x = __builtin_amdgcn_mfma_f32_32x32x16_bf16(k3, qf[3], x, 0, 0, 0);
    x = __builtin_amdgcn_mfma_f32_32x32x16_bf16(k4, qf[4], x, 0, 0, 0); x = __builtin_amdgcn_mfma_f32_32x32x16_bf16(k5, qf[5], x, 0, 0, 0);
    x = __builtin_amdgcn_mfma_f32_32x32x16_bf16(k6, qf[6], x, 0, 0, 0); x = __builtin_amdgcn_mfma_f32_32x32x16_bf16(k7, qf[7], x, 0, 0, 0);
    return x;
}
__device__ __forceinline__ void pv_slot(f32x16 (&o)[4], const TAddr& A, unsigned so, const f32x16& p) {
    s16x8 pf[2];
#pragma unroll
    for (int s = 0; s < 2; ++s) { f32x8 t;
#pragma unroll
        for (int j = 0; j < 8; ++j) t[j] = p[8 * s + j];
        pf[s] = __builtin_bit_cast(s16x8, __builtin_convertvector(t, bf16x8_t)); }
    const unsigned R0 = A.vR + so + ((A.vY ^ 0u) << 4), R1 = A.vR + so + 2048u + ((A.vY ^ 2u) << 4), Q = A.vQ;
    s16x4 v0, v1, v2, v3, v4, v5, v6, v7, v8, v9, v10, v11, v12, v13, v14, v15;
    asm volatile("ds_read_b64_tr_b16 %0, %16\n\tds_read_b64_tr_b16 %1, %17\n\tds_read_b64_tr_b16 %2, %16 offset:4096\n\tds_read_b64_tr_b16 %3, %17 offset:4096\n\t"
                 "ds_read_b64_tr_b16 %4, %18\n\tds_read_b64_tr_b16 %5, %19\n\tds_read_b64_tr_b16 %6, %18 offset:4096\n\tds_read_b64_tr_b16 %7, %19 offset:4096\n\t"
                 "ds_read_b64_tr_b16 %8, %20\n\tds_read_b64_tr_b16 %9, %21\n\tds_read_b64_tr_b16 %10, %20 offset:4096\n\tds_read_b64_tr_b16 %11, %21 offset:4096\n\t"
                 "ds_read_b64_tr_b16 %12, %22\n\tds_read_b64_tr_b16 %13, %23\n\tds_read_b64_tr_b16 %14, %22 offset:4096\n\tds_read_b64_tr_b16 %15, %23 offset:4096\n\ts_waitcnt lgkmcnt(0)"
                 : "=&v"(v0), "=&v"(v1), "=&v"(v2), "=&v"(v3), "=&v"(v4), "=&v"(v5), "=&v"(v6), "=&v"(v7), "=&v"(v8), "=&v"(v9), "=&v"(v10), "=&v"(v11), "=&v"(v12), "=&v"(v13), "=&v"(v14), "=&v"(v15)
                 : "v"(R0 + ((0u ^ Q) << 6)), "v"(R1 + ((0u ^ Q) << 6)), "v"(R0 + ((1u ^ Q) << 6)), "v"(R1 + ((1u ^ Q) << 6)), "v"(R0 + ((2u ^ Q) << 6)), "v"(R1 + ((2u ^ Q) << 6)), "v"(R0 + ((3u ^ Q) << 6)), "v"(R1 + ((3u ^ Q) << 6)) : "memory");
#define FB_VF(a, b) __builtin_shufflevector(a, b, 0, 1, 2, 3, 4, 5, 6, 7)
    o[0] = __builtin_amdgcn_mfma_f32_32x32x16_bf16(FB_VF(v0, v1), pf[0], o[0], 0, 0, 0);   o[1] = __builtin_amdgcn_mfma_f32_32x32x16_bf16(FB_VF(v4, v5), pf[0], o[1], 0, 0, 0);
    o[2] = __builtin_amdgcn_mfma_f32_32x32x16_bf16(FB_VF(v8, v9), pf[0], o[2], 0, 0, 0);   o[3] = __builtin_amdgcn_mfma_f32_32x32x16_bf16(FB_VF(v12, v13), pf[0], o[3], 0, 0, 0);
    o[0] = __builtin_amdgcn_mfma_f32_32x32x16_bf16(FB_VF(v2, v3), pf[1], o[0], 0, 0, 0);   o[1] = __builtin_amdgcn_mfma_f32_32x32x16_bf16(FB_VF(v6, v7), pf[1], o[1], 0, 0, 0);
    o[2] = __builtin_amdgcn_mfma_f32_32x32x16_bf16(FB_VF(v10, v11), pf[1], o[2], 0, 0, 0); o[3] = __builtin_amdgcn_mfma_f32_32x32x16_bf16(FB_VF(v14, v15), pf[1], o[3], 0, 0, 0);
#undef FB_VF
}
__device__ __forceinline__ f32x16 dl_probs(const f32x16& x, f32x16 (&o)[4], float& m, float& l, const LAS float* tab, int KB, bool edge, int kmin, int r, int hh) {
    const int lane = r + 32 * hh;
    const LAS float* tp = tab + (TAB_PAD + 128 + r - 32 * KB - 4 * hh - 27);
    const int klo = kmin - 32 * KB - 4 * hh;
    float tb[16];
#pragma unroll
    for (int e = 0; e < 16; ++e) tb[e] = tp[27 - ((e & 3) + 8 * (e >> 2))];
    f32x16 s;
#pragma unroll
    for (int e = 0; e < 16; ++e) s[e] = x[e] * SC2 + tb[e];
    if (KB == 4) {
#pragma unroll
        for (int e = 0; e < 16; ++e) s[e] = (((e & 3) + 8 * (e >> 2)) + 4 * hh <= r) ? s[e] : NEG_BIG; }
    if (KB == 0) {
#pragma unroll
        for (int e = 0; e < 16; ++e) s[e] = (((e & 3) + 8 * (e >> 2)) + 4 * hh >= r) ? s[e] : NEG_BIG; }
    if (edge) {
#pragma unroll
        for (int e = 0; e < 16; ++e) s[e] = (((e & 3) + 8 * (e >> 2)) >= klo) ? s[e] : NEG_BIG; }
    float bm = NEG_BIG;
#pragma unroll
    for (int e = 0; e < 16; ++e) bm = fmaxf(bm, s[e]);
    bm = fmaxf(bm, xor_lane(bm, 32, lane));
    if (__any(bm > m + DEFER)) {
        const float mn = fmaxf(m, bm), alpha = __builtin_amdgcn_exp2f(m - mn);
        m = mn; l *= alpha;
#pragma unroll
        for (int db = 0; db < 4; ++db)
#pragma unroll
            for (int e = 0; e < 16; ++e) o[db][e] *= alpha;
    }
    f32x16 p; float ls = 0.f;
#pragma unroll
    for (int e = 0; e < 16; ++e) { p[e] = __builtin_amdgcn_exp2f(s[e] - m); ls += p[e]; }
    l += ls;
    return p;
}
#define FB_BAR() do { asm volatile("" ::: "memory"); __builtin_amdgcn_s_barrier(); asm volatile("" ::: "memory"); } while (0)
__device__ __forceinline__ void dl_chunk(Frame& F, LAS unsigned char* ring, const LAS float* tab, const bf16* PROJ, bf16* DLP, float* LSE, bf16* O, const float* ghead, int b, int hd, int C0, int dil, int grp, int lane) {
    const int i = F.wave & 3, r = lane & 31, hh = lane >> 5;
    const bf16* base = PROJ + (size_t)b * SEQ * PJP;
    TAddr A; team_addr(A, ring, i, dil, lane);
    const int P0 = C0 + 32 * i * dil;
    s16x8 qf[8]; fa::load_q(qf, base + (size_t)(P0 + r * dil) * PJP + 3072 + hd * HD, lane);
    f32x16 o[4];
#pragma unroll
    for (int db = 0; db < 4; ++db)
#pragma unroll
        for (int e = 0; e < 16; ++e) o[db][e] = 0.f;
    float m = NEG_BIG, l = 0.f;
    const int kmin = 128 - P0 / dil; const bool edge = kmin > 0;
    const char* kc = (const char*)(base + (size_t)C0 * PJP + 4096 + hd * HD);
    const long BLK = 32L * dil * PJP * 2;
#define FB_KB0(J) (kc + ((C0 + (32 * (J) - 97) * dil) < 0 ? 0L : (long)((J) - 4) * BLK))
    team_issue(ring + 16384 * (7 & 3), i, FB_KB0(7), A);
    team_issue(ring + 16384 * (6 & 3), i, FB_KB0(6), A);
    team_issue(ring + 16384 * (5 & 3), i, FB_KB0(5), A);
#pragma unroll 1
    for (int J = 7; J >= 0; --J) {
        if (J >= 2) FA_WAIT_V(8);
        else if (J == 1) FA_WAIT_V(4);
        else FA_WAIT_V(0);
        FB_BAR();
        if (J >= 3) team_issue(ring + 16384 * ((J - 3) & 3), i, FB_KB0(J - 3), A);
        const int KB = J - i;
        if (KB >= 0 && KB <= 4 && 32 * KB + 31 >= kmin) {
            const unsigned so = 16384u * (unsigned)(J & 3);
            const f32x16 x = qk_slot(A, so, qf);
            const f32x16 p = dl_probs(x, o, m, l, tab, KB, edge, kmin, r, hh);
            pv_slot(o, A, so, p);
        }
    }
#undef FB_KB0
    l += xor_lane(l, 32, lane);
    if (grp != 0) fa::dl_store_partial(o, m, l, DLP, LSE, grp, b, hd, P0, dil, opaque_v(lane));
    else fa::dl_combine_store(o, m, l, DLP, LSE, O, ghead, b, hd, P0, opaque_v(lane));
}
__device__ __forceinline__ void sb_chunk(Frame& F, LAS unsigned char* ring, volatile LAS unsigned* votes, const bf16* PROJ, bf16* O, const float* ghead, int b, int h, int C0, int lane) {
    const int i = F.wave & 3, r = lane & 31, hh = lane >> 5;
    const bf16* base = PROJ + (size_t)b * SEQ * PJP;
    TAddr A; team_addr(A, ring, i, 1, lane);
    const int t0 = C0 + 32 * i;
    s16x8 qf[8]; fa::load_q(qf, base + (size_t)(t0 + r) * PJP + h * HD, lane);
    f32x16 o[4];
#pragma unroll
    for (int db = 0; db < 4; ++db)
#pragma unroll
        for (int e = 0; e < 16; ++e) o[db][e] = 0.f;
    float carry = 0.f; bool done = false;
    const char* kc = (const char*)(base + (size_t)C0 * PJP + 1024 + h * HD);
    constexpr long BLK = 32L * PJP * 2;
    const int Jmin = -(C0 >> 5);
#define FB_KB0(J) (kc + (long)((J) < Jmin ? Jmin : (J)) * BLK)
    team_issue(ring + 16384 * (3 & 3), i, FB_KB0(3), A);
    team_issue(ring + 16384 * (2 & 3), i, FB_KB0(2), A);
    team_issue(ring + 16384 * (1 & 3), i, FB_KB0(1), A);
    int par = 0;
#pragma unroll 1
    for (int J = 3; ; --J) {
        FA_WAIT_V(8);
        if (lane == 0) votes[8 * par + F.wave] = (done || J < Jmin) ? 1u : 0u;
        asm volatile("s_waitcnt lgkmcnt(0)" ::: "memory");
        FB_BAR();
        unsigned nd = 0;
#pragma unroll
        for (int k = 0; k < 8; ++k) nd += votes[8 * par + k];
        par ^= 1;
        if (nd == 8u) break;
        team_issue(ring + 16384 * ((J - 3) & 3), i, FB_KB0(J - 3), A);
        if (!done && J <= i && J >= Jmin) {
            const unsigned so = 16384u * (unsigned)(J & 3);
            const f32x16 x = qk_slot(A, so, qf);
            f32x16 p;
            if (J == i) p = fa::sb_weights<true>(x, carry, r - 4 * hh, hh, lane); else p = fa::sb_weights<false>(x, carry, 0, hh, lane);
            pv_slot(o, A, so, p);
            done = __all(carry < SB_EXIT);
        }
    }
#undef FB_KB0
    fa::headnorm_store(o, O + ((size_t)b * SEQ + t0 + r) * DM + h * HD, ghead + h * HD, lane);
    FA_WAIT_V(16);
}
}
__device__ __forceinline__ void dl_tables_all(LAS float* tab, const float* relb) {
    for (int e = (int)threadIdx.x; e < NHD * 3 * fa::TAB_STRIDE; e += NWAVES * 64) { const int h = e / (3 * fa::TAB_STRIDE), e2 = e % (3 * fa::TAB_STRIDE), grp = e2 / fa::TAB_STRIDE, rel = e2 % fa::TAB_STRIDE - fa::TAB_PAD, dil = grp == 0 ? 1 : (grp == 1 ? 4 : 16);
        tab[e] = (rel >= 0 && rel <= 128) ? relb[t5_bucket(rel * dil) * NHD + h] * LOG2E : 0.f; }
}
__device__ __forceinline__ void attn_phase_a(Frame& F, const bf16* PROJ, bf16* DLP, float* LSE) {
    const int lane = lane_now(), w = F.wave;
    LAS unsigned char* ring = F.lds + RING_OFF + (w >> 2) * 65536;
    const LAS float* tab = (const LAS float*)(F.lds + TAB_OFF);
    const int b = F.vcu >> 5, T = (F.vcu & 31) * 2 + (w >> 2);
#pragma unroll 1
    for (int h = 0; h < NHD; ++h) {
        const LAS float* th = tab + h * 3 * fa::TAB_STRIDE;
        if (T < 32) fb::dl_chunk(F, ring, th + 2 * fa::TAB_STRIDE, PROJ, DLP, LSE, nullptr, nullptr, b, h, (128 * (T & 1)) * 16 + (T >> 1), 16, 2, opaque_v(lane));
        else        fb::dl_chunk(F, ring, th + 1 * fa::TAB_STRIDE, PROJ, DLP, LSE, nullptr, nullptr, b, h, (128 * ((T - 32) & 7)) * 4 + ((T - 32) >> 3), 4, 1, opaque_v(lane));
    }
    FA_WAIT_V(0);
}
__device__ __forceinline__ void attn_phase_b(Frame& F, const bf16* PROJ, bf16* O, bf16* DLP, float* LSE, const float* ghead) {
    const int lane = lane_now(), w = F.wave;
    LAS unsigned char* ring = F.lds + RING_OFF + (w >> 2) * 65536;
    const LAS float* tab = (const LAS float*)(F.lds + TAB_OFF);
    volatile LAS unsigned* votes = (volatile LAS unsigned*)(F.lds + VOTE_OFF);
    const int b = F.vcu >> 5, j = F.vcu & 31, c = (j & 15) * 2 + (w >> 2);
#pragma unroll 1
    for (int h = 0; h < 8; ++h) {
        const bool dl_role = ((j >> 4) ^ (h & 1)) == 0;
        if (dl_role) fb::dl_chunk(F, ring, tab + h * 3 * fa::TAB_STRIDE, PROJ, DLP, LSE, O, ghead, b, h, 128 * c, 1, 0, opaque_v(lane));
        else fb::sb_chunk(F, ring, votes, PROJ, O, ghead, b, h, 128 * c, opaque_v(lane));
    }
    FA_WAIT_V(0);
}
__global__ void __launch_bounds__(NWAVES * 64, 2) mega_fwd(Args args) {
    extern __shared__ __attribute__((aligned(16))) unsigned char lds[];
    Frame F;
    F.lds = (LAS unsigned char*)lds;
    F.MISC = (volatile LAS unsigned*)(F.lds + MISC_OFF);
    F.wave = __builtin_amdgcn_readfirstlane((int)threadIdx.x >> 6);
    F.G = gridDim.x; { const int bx = blockIdx.x; F.vcu = (F.G % 8 == 0) ? (bx % 8) * (F.G / 8) + bx / 8 : bx; }
    unsigned char* ws = args.ws;
    F.ctl = (gu32*)(ws + WS_CTL);
    for (int u = (int)threadIdx.x; u < (LDS_BYTES - LDSCTL_OFF) / 4; u += NWAVES * 64) ((LAS unsigned*)(F.lds + LDSCTL_OFF))[u] = 0u;
    __syncthreads();
    dl_tables_all((LAS float*)(F.lds + TAB_OFF), args.in[7]);
    __syncthreads();
    const int lo = args.ph_lo, hi = args.ph_hi;
    const bool use_bar = (hi - lo) > 1;
    XcdBarrier bar; bar.bar = (unsigned*)(F.ctl + CW_BAR); bar.x = 0; bar.st = nullptr;
    if (use_bar) bar = xcd_barrier_post((unsigned*)(F.ctl + CW_BAR), F.MISC + 8);
#define IN(k) (lo <= (k) && (k) < hi)
#define SEAM(k) do { if (IN(k) && IN((k) + 1)) xcd_barrier(bar); } while (0)
    bf16* const H = (bf16*)(ws + WS_H); bf16* const PROJ = (bf16*)(ws + WS_PROJ); bf16* const ACT = (bf16*)(ws + WS_PROJ);
    bf16* const OB = (bf16*)(ws + WS_O); bf16* const Y = (bf16*)(ws + WS_Y); bf16* const P16 = (bf16*)(ws + WS_P16);
    float* const out = args.out;
    unsigned short* const XH = (unsigned short*)(ws + WS_XH);

    if (IN(0)) { convert_weights(F, args); norm_only_phase(F, args.in[0], nullptr, args.in[2], H); }
    SEAM(0);
    for (int L = 0; L < DEPTH; ++L) {
        const int p0 = 1 + L * PH_PER_LAYER;
        unsigned char* wl = ws + WS_W + (size_t)L * W_LAYER;
        const float* x32 = (L == 0) ? args.in[0] : nullptr;
        if (IN(p0 + 0)) { pg8::Gemm g{H, (const bf16*)(wl + WO_IN), M, INW, DM, DM}; pg8::StaticOrder S; S.init(M, INW, F.G, (int)blockIdx.x);
            pg8::EpiStore E{PROJ, PJP}; pg8::gemm_phase<pg8::EpiStore, pg8::StaticOrder, true, true>(F.lds + RING_OFF, g, S, E); }
        SEAM(p0 + 0);
        if (IN(p0 + 1)) {
            attn_phase_a(F, PROJ, (bf16*)(ws + WS_DLP), (float*)(ws + WS_LSE));
        }
        SEAM(p0 + 1);
        if (IN(p0 + 2)) {
            attn_phase_b(F, PROJ, OB, (bf16*)(ws + WS_DLP), (float*)(ws + WS_LSE), args.in[4] + (size_t)L * DM);
        }
        SEAM(p0 + 2);
        if (IN(p0 + 3)) { pg8::Gemm g{OB, (const bf16*)(wl + WO_OUT), M, DM, DM, DM}; pg8::StaticOrder S; S.init(M, DM, F.G, (int)blockIdx.x);
            pg8::EpiStore E{Y, DM}; pg8::gemm_phase<pg8::EpiStore, pg8::StaticOrder, true, true>(F.lds + RING_OFF, g, S, E); }
        SEAM(p0 + 3);
        if (IN(p0 + 4)) { resid_norm_phase(F, x32, XH, XH, Y, args.in[6] + (size_t)L * DM, args.in[8] + (size_t)L * DM, H, nullptr, nullptr); }
        SEAM(p0 + 4);
        if (IN(p0 + 5)) { pg8::Gemm g{H, (const bf16*)(wl + WO_GU), M, 2 * DFF, DM, DM}; pg8::StaticOrder S; S.init(M, 2 * DFF, F.G, (int)blockIdx.x);
            pg8::EpiSwiGLU E{ACT, PJP}; pg8::gemm_phase<pg8::EpiSwiGLU, pg8::StaticOrder, true, true>(F.lds + RING_OFF, g, S, E); }
        SEAM(p0 + 5);
        if (IN(p0 + 6)) { pg8::Gemm g{ACT, (const bf16*)(wl + WO_DN), M, DM, DFF, PJP};   pg8::StaticOrder S; S.init(M, DM, F.G, (int)blockIdx.x);
            pg8::EpiStore E{Y, DM}; pg8::gemm_phase<pg8::EpiStore, pg8::StaticOrder, true, true>(F.lds + RING_OFF, g, S, E); }
        SEAM(p0 + 6);
        if (IN(p0 + 7)) { resid_norm_phase(F, nullptr, XH, XH, Y, args.in[11] + (size_t)L * DM, args.in[12] + (size_t)L * DM, H, args.in[1] + (size_t)L * M * PLI, P16); }
        SEAM(p0 + 7);
        if (IN(p0 + 8)) {
            { pg8::Gemm g{P16, (const bf16*)(wl + WO_PP), M, DM, PLI, PLI}; pg8::StaticOrder S; S.init(M, DM, F.G, (int)blockIdx.x);
              pg8::EpiStore E{Y, DM}; pg8::gemm_phase<pg8::EpiStore, pg8::StaticOrder, true, true>(F.lds + RING_OFF, g, S, E); }
            __syncthreads();
            { pg8::Gemm g{H, (const bf16*)(wl + WO_PG), M, DM, DM, DM}; pg8::StaticOrder S; S.init(M, DM, F.G, (int)blockIdx.x);
              pg8::EpiPli E{XH, XH, (L + 1 == DEPTH) ? out : nullptr, Y, DM};     pg8::gemm_phase<pg8::EpiPli, pg8::StaticOrder, true, true>(F.lds + RING_OFF, g, S, E); }
        }
        SEAM(p0 + 8);
        if (IN(p0 + 9) && L + 1 < DEPTH) { norm_only_phase(F, nullptr, XH, args.in[2] + (size_t)(L + 1) * DM, H); }
        SEAM(p0 + 9);
    }
#undef IN
#undef SEAM
}

extern "C" void kernel_launch(void* const* d_in, const int* in_sizes, int n_in, void* d_out, int out_size, void* d_ws, size_t ws_size, hipStream_t stream) {
    static int grid = 0;
    if (grid == 0) {
        if (n_in != 15 || in_sizes[0] != M * DM || out_size != M * DM || ws_size < WS_END) { fprintf(stderr, "kernel_launch: unexpected shapes or workspace (n_in %d, in0 %d, out %d, ws %zu < %zu); nothing launched\n", n_in, n_in > 0 ? in_sizes[0] : -1, out_size, ws_size, (size_t)WS_END); grid = -1; return; }
        int dev = 0, cus = 0, per_cu = 0;
        if (hipGetDevice(&dev) != hipSuccess || hipDeviceGetAttribute(&cus, hipDeviceAttributeMultiprocessorCount, dev) != hipSuccess) { fprintf(stderr, "kernel_launch: device query failed\n"); grid = -1; return; }
        if (hipFuncSetAttribute((const void*)mega_fwd, hipFuncAttributeMaxDynamicSharedMemorySize, LDS_BYTES) != hipSuccess) { fprintf(stderr, "kernel_launch: hipFuncSetAttribute failed\n"); grid = -1; return; }
        if (hipOccupancyMaxActiveBlocksPerMultiprocessor(&per_cu, (const void*)mega_fwd, NWAVES * 64, LDS_BYTES) != hipSuccess || per_cu < 1)
            fprintf(stderr, "kernel_launch: note: occupancy query reports %d workgroups per CU\n", per_cu);
        (void)hipGetLastError();
        if (cus != 256) { fprintf(stderr, "kernel_launch: built for a 256-CU device (the token-mixing phases deal work per XCD group of 32 workgroups); found %d CUs; nothing launched\n", cus); grid = -1; return; }
        grid = cus;
    }
    if (grid < 0) return;
    if (hipMemsetAsync((char*)d_ws + WS_CTL, 0, CTL_ZERO_BYTES, stream) != hipSuccess) { fprintf(stderr, "kernel_launch: memset failed\n"); return; }
    Args a{};
    for (int i = 0; i < 15; ++i) a.in[i] = (const float*)d_in[i];
    a.out = (float*)d_out; a.ws = (unsigned char*)d_ws;
#if MK_N_LAUNCHES == 1
    a.ph_lo = 0; a.ph_hi = N_PHASES; a.li = 0;
    hipLaunchKernelGGL(mega_fwd, dim3(grid), dim3(NWAVES * 64), LDS_BYTES, stream, a);
#else
    for (int p = 0; p < N_PHASES - 1; ++p) { a.ph_lo = p; a.ph_hi = p + 1; a.li = p;
        hipLaunchKernelGGL(mega_fwd, dim3(grid), dim3(NWAVES * 64), LDS_BYTES, stream, a); }
#endif
    const hipError_t le = hipPeekAtLastError();
    if (le != hipSuccess) fprintf(stderr, "kernel_launch: launch failed: %s\n", hipGetErrorName(le));
}
```

```cpp
#define MK_N_LAUNCHES 1
#include <hip/hip_runtime.h>
#include <cstdio>
#include <cstdint>
namespace pg8 {
#define PG8_LAS __attribute__((address_space(3)))
typedef unsigned short bf16_t;
typedef short bf16x8 __attribute__((ext_vector_type(8)));
typedef float f32x4 __attribute__((ext_vector_type(4)));
typedef unsigned u32x4 __attribute__((ext_vector_type(4)));
constexpr int BM = 256, BK = 64, HALF = 128, HTB = HALF * BK * 2  , STAGE_BYTES = 8 * HTB, NXCD = 8, WGM = 4;

__host__ __device__ __forceinline__ int lds_byte(int r, int c) { const int st = (r >> 4) * 2 + (c >> 5), rr = r & 15, cc = c & 31, ob = rr * 64 + cc * 2; return st * 1024 + (ob ^ (((ob >> 9) & 1) << 5)); }
__host__ __device__ __forceinline__ void stage_rc(int b, int& R, int& C) { const int st = b / 1024, sb = b % 1024, swz = sb ^ (((sb >> 9) & 1) << 5); R = (st >> 1) * 16 + swz / 64; C = (st & 1) * 32 + (swz % 64) / 2; }
__host__ __device__ __forceinline__ int perm32(int rho) { const int n = rho >> 4, i = rho & 15; return 8 * (i >> 2) + 4 * n + (i & 3); }

struct Unit { int pm, pn; };
struct Gemm { const bf16_t* A; const bf16_t* Bt; int M, N, K, lda; };

struct StaticOrder {
    int nM, nN, nwg, G, c;
    __host__ __device__ void init(int M, int N, int G_, int c_) { nM = M / BM; nN = N / BM; nwg = nM * nN; G = G_; c = c_; }
    __host__ __device__ bool next(int i, Unit& u) const {
        const long L = (long)i * G + c; if (L >= nwg) return false;
        int wgid = (int)L; { const int q = nwg / NXCD, r = nwg % NXCD, xcd = wgid % NXCD, off = wgid / NXCD; wgid = (xcd < r ? xcd * (q + 1) : r * (q + 1) + (xcd - r) * q) + off; }
        const int nig = WGM * nN, gid = wgid / nig, fm = gid * WGM, gsz = (nM - fm) < WGM ? (nM - fm) : WGM;
        u.pm = fm + ((wgid % nig) % gsz); u.pn = (wgid % nig) / gsz; return true;
    }
    __device__ __forceinline__ void a_ready(const Unit&) const {}
    __device__ __forceinline__ void done(const Unit&) const {}
};

__device__ __forceinline__ unsigned cvt_pk_bf16(float lo, float hi) { unsigned r; asm volatile("v_cvt_pk_bf16_f32 %0, %1, %2" : "=v"(r) : "v"(lo), "v"(hi)); return r; }
typedef float f32x2 __attribute__((ext_vector_type(2)));
__device__ __forceinline__ f32x2 gelu_pk(f32x2 v) {
    const f32x2 av = __builtin_elementwise_abs(v), d = av * 0.2316418882f + 1.0f;
    f32x2 t; t.x = __builtin_amdgcn_rcpf(d.x); t.y = __builtin_amdgcn_rcpf(d.y);
    f32x2 q = t * 0.5307027145f + (-0.7265760135f); q = q * t + 0.7107068705f; q = q * t + (-0.142248368f); q = q * t + 0.127414796f; q = q * t;
    const f32x2 s = (v * v) * (-0.72134752044f);
    f32x2 e; e.x = __builtin_amdgcn_exp2f(s.x); e.y = __builtin_amdgcn_exp2f(s.y);
    const f32x2 m = v * (q * e), r = v - m;
    f32x2 o; o.x = v.x < 0.f ? m.x : r.x; o.y = v.y < 0.f ? m.y : r.y; return o;
}

template <int ACT  > struct EpiBf16 {
    static constexpr bool PERM = true, AFTER_DRAIN = false; static_assert(ACT == 0 || ACT == 1, "EpiBf16: ACT is 0 (none) or 1 (gelu_pk)");
    bf16_t* O; int ldc; const float* bias; int split_cols; size_t split_stride; float scale0;
    __device__ __forceinline__ void operator()(const f32x4 (&acc)[2][2][4][2], const Unit& u, int wr, int wc, int fr, int fq) const {
        const int row0 = u.pm * BM + wr * 64 + fr; int colt = u.pn * BM; bf16_t* base = O;
        float sc = 1.f; if (split_cols) { const int t = colt / split_cols; base += (size_t)t * split_stride; colt -= t * split_cols; if (t == 0) sc = scale0; }
        const int col0 = colt + wc * 32 + 8 * fq, bcol0 = u.pn * BM + wc * 32 + 8 * fq;
        f32x4 bv[2][2];
#pragma unroll
        for (int bj = 0; bj < 2; ++bj)
#pragma unroll
            for (int n = 0; n < 2; ++n) bv[bj][n] = bias ? *(const f32x4*)(bias + bcol0 + bj * HALF + 4 * n) : (f32x4){0.f, 0.f, 0.f, 0.f};
#pragma unroll
        for (int ai = 0; ai < 2; ++ai)
#pragma unroll
            for (int m = 0; m < 4; ++m) { bf16_t* rowp = base + (size_t)(row0 + ai * HALF + m * 16) * ldc + col0;
#pragma unroll
                for (int bj = 0; bj < 2; ++bj) { f32x4 v0 = acc[ai][bj][m][0] + bv[bj][0], v1 = acc[ai][bj][m][1] + bv[bj][1];
                    if (ACT == 1) { f32x2 a = gelu_pk((f32x2){v0[0], v0[1]}), b = gelu_pk((f32x2){v0[2], v0[3]}), c = gelu_pk((f32x2){v1[0], v1[1]}), d = gelu_pk((f32x2){v1[2], v1[3]});
                        v0 = (f32x4){a.x, a.y, b.x, b.y}; v1 = (f32x4){c.x, c.y, d.x, d.y}; }
                    v0 = v0 * sc; v1 = v1 * sc; u32x4 w; w.x = cvt_pk_bf16(v0[0], v0[1]); w.y = cvt_pk_bf16(v0[2], v0[3]); w.z = cvt_pk_bf16(v1[0], v1[1]); w.w = cvt_pk_bf16(v1[2], v1[3]);
                    *(u32x4*)(rowp + bj * HALF) = w; } }
    }
};
struct EpiStore {
    static constexpr bool PERM = true, AFTER_DRAIN = false;
    bf16_t* O; int ldc;
    __device__ __forceinline__ void operator()(const f32x4 (&acc)[2][2][4][2], const Unit& u, int wr, int wc, int fr, int fq) const {
        const int row0 = u.pm * BM + wr * 64 + fr, col0 = u.pn * BM + wc * 32 + 8 * fq;
#pragma unroll
        for (int ai = 0; ai < 2; ++ai)
#pragma unroll
            for (int m = 0; m < 4; ++m) { bf16_t* rowp = O + (size_t)(row0 + ai * HALF + m * 16) * ldc + col0;
#pragma unroll
                for (int bj = 0; bj < 2; ++bj) { const f32x4 v0 = acc[ai][bj][m][0], v1 = acc[ai][bj][m][1];
                    u32x4 w; w.x = cvt_pk_bf16(v0[0], v0[1]); w.y = cvt_pk_bf16(v0[2], v0[3]); w.z = cvt_pk_bf16(v1[0], v1[1]); w.w = cvt_pk_bf16(v1[2], v1[3]);
                    *(u32x4*)(rowp + bj * HALF) = w; } }
    }
};
__device__ __forceinline__ float sigmoid_f(float v) { return __builtin_amdgcn_rcpf(1.0f + __builtin_amdgcn_exp2f(-1.44269504089f * v)); }
struct EpiSwiGLU {
    static constexpr bool PERM = true, AFTER_DRAIN = false;
    bf16_t* O; int ldc;
    __device__ __forceinline__ void operator()(const f32x4 (&acc)[2][2][4][2], const Unit& u, int wr, int wc, int fr, int fq) const {
        const int row0 = u.pm * BM + wr * 64 + fr, col0 = u.pn * HALF + wc * 32 + 8 * fq;
#pragma unroll
        for (int ai = 0; ai < 2; ++ai)
#pragma unroll
            for (int m = 0; m < 4; ++m) { bf16_t* rowp = O + (size_t)(row0 + ai * HALF + m * 16) * ldc + col0;
                f32x4 r0, r1; const f32x4 g0 = acc[ai][0][m][0], g1 = acc[ai][0][m][1], u0 = acc[ai][1][m][0], u1 = acc[ai][1][m][1];
#pragma unroll
                for (int j = 0; j < 4; ++j) { r0[j] = g0[j] * sigmoid_f(g0[j]) * u0[j]; r1[j] = g1[j] * sigmoid_f(g1[j]) * u1[j]; }
                u32x4 w; w.x = cvt_pk_bf16(r0[0], r0[1]); w.y = cvt_pk_bf16(r0[2], r0[3]); w.z = cvt_pk_bf16(r1[0], r1[1]); w.w = cvt_pk_bf16(r1[2], r1[3]);
                *(u32x4*)rowp = w; }
    }
};
typedef _Float16 h16x2 __attribute__((ext_vector_type(2)));
typedef float f32x2v __attribute__((ext_vector_type(2)));
__device__ __forceinline__ unsigned pkh2(float a, float b) { const f32x2v v = {a, b}; return __builtin_bit_cast(unsigned, __builtin_convertvector(v, h16x2)); }
__device__ __forceinline__ float h_lo(unsigned u) { return (float)__builtin_bit_cast(h16x2, u)[0]; }
__device__ __forceinline__ float h_hi(unsigned u) { return (float)__builtin_bit_cast(h16x2, u)[1]; }
struct EpiPli {
    static constexpr bool PERM = true, AFTER_DRAIN = false;
    const bf16_t* X; bf16_t* Xo; float* Of; const bf16_t* PP; int ldc;
    __device__ __forceinline__ void operator()(const f32x4 (&acc)[2][2][4][2], const Unit& u, int wr, int wc, int fr, int fq) const {
        const int row0 = u.pm * BM + wr * 64 + fr, col0 = u.pn * BM + wc * 32 + 8 * fq;
        u32x4 pp[3][2], xh[3][2];
#define PLI_LOAD(s) do { const size_t off_ = (size_t)(row0 + ((s) >> 2) * HALF + ((s) & 3) * 16) * ldc + col0; \
            pp[(s) % 3][0] = *(const u32x4*)(PP + off_); xh[(s) % 3][0] = *(const u32x4*)(X + off_); pp[(s) % 3][1] = *(const u32x4*)(PP + off_ + HALF); xh[(s) % 3][1] = *(const u32x4*)(X + off_ + HALF); } while (0)
        PLI_LOAD(0); PLI_LOAD(1);
#pragma unroll
        for (int s = 0; s < 8; ++s) {
            if (s + 2 < 8) PLI_LOAD(s + 2);
            asm volatile("" ::: "memory");
            const int ai = s >> 2, m = s & 3;
#pragma unroll
            for (int bj = 0; bj < 2; ++bj) { const size_t off = (size_t)(row0 + ai * HALF + m * 16) * ldc + col0 + bj * HALF;
                const f32x4 a0 = acc[ai][bj][m][0], a1 = acc[ai][bj][m][1]; const u32x4 p = pp[s % 3][bj], x = xh[s % 3][bj]; f32x4 y0, y1;
                y0[0] = h_lo(x.x) + sigmoid_f(a0[0]) * __uint_as_float(p.x << 16); y0[1] = h_hi(x.x) + sigmoid_f(a0[1]) * __uint_as_float(p.x & 0xffff0000u);
                y0[2] = h_lo(x.y) + sigmoid_f(a0[2]) * __uint_as_float(p.y << 16); y0[3] = h_hi(x.y) + sigmoid_f(a0[3]) * __uint_as_float(p.y & 0xffff0000u);
                y1[0] = h_lo(x.z) + sigmoid_f(a1[0]) * __uint_as_float(p.z << 16); y1[1] = h_hi(x.z) + sigmoid_f(a1[1]) * __uint_as_float(p.z & 0xffff0000u);
                y1[2] = h_lo(x.w) + sigmoid_f(a1[2]) * __uint_as_float(p.w << 16); y1[3] = h_hi(x.w) + sigmoid_f(a1[3]) * __uint_as_float(p.w & 0xffff0000u);
                if (Of) { *(f32x4*)(Of + off) = y0; *(f32x4*)(Of + off + 4) = y1; }
                else { u32x4 w; w.x = pkh2(y0[0], y0[1]); w.y = pkh2(y0[2], y0[3]); w.z = pkh2(y1[0], y1[1]); w.w = pkh2(y1[2], y1[3]); *(u32x4*)(Xo + off) = w; } }
            asm volatile("" ::: "memory");
        }
#undef PLI_LOAD
    }
};
template <class Epi, class Sched, bool ALIGN_EPI = false, bool SP2 = false>
__device__ __forceinline__ void gemm_phase(PG8_LAS unsigned char* lds, const Gemm g, const Sched& S, const Epi& E) {
    int tid_ = threadIdx.x; asm volatile("" : "+v"(tid_));
    const int tid = tid_, wid = __builtin_amdgcn_readfirstlane(tid >> 6), lane = tid & 63, wr = wid >> 2, wc = wid & 3, fr = lane & 15, fq = lane >> 4;
    int K_ = g.K; asm volatile("" : "+s"(K_));
    int lda_ = g.lda; asm volatile("" : "+s"(lda_));
    const int K = K_, nt = K / BK;
    unsigned voffA[2], voffB[2];
#pragma unroll
    for (int i = 0; i < 2; ++i) { int R, C; stage_rc(tid * 16 + i * 8192, R, C); const int Rb = Epi::PERM ? ((R & ~31) + perm32(R & 31)) : R;
        voffA[i] = (unsigned)(R * lda_ + C) * 2u; voffB[i] = (unsigned)(Rb * K + C) * 2u; }
    const size_t kstep = (size_t)(BK * 2);
    const size_t hstep = (size_t)HALF * K * 2, hstepA = (size_t)HALF * lda_ * 2;
    const size_t tstep = 2 * hstep, tstepA = 2 * hstepA;
    const unsigned ldsw = (unsigned)wid * 1024u;
    const int aoff = lds_byte(wr * 64 + fr, fq * 8), boff = lds_byte(wc * 32 + fr, fq * 8);
#define PG8_SA(b, h) (((b) * 2 + (h)) * HTB)
#define PG8_SB(b, h) ((4 + (b) * 2 + (h)) * HTB)
#define PG8_STAGE(bufoff, gbase, voff) do { _Pragma("unroll") for (int _i = 0; _i < 2; ++_i) \
        __builtin_amdgcn_global_load_lds((const unsigned*)((const char*)(gbase) + (voff)[_i]), (PG8_LAS unsigned*)(lds + (bufoff) + ldsw + _i * 8192), 16, 0, 0); } while (0)
#define PG8_LDA(dst, b, h) do { _Pragma("unroll") for (int m = 0; m < 4; ++m) _Pragma("unroll") for (int k = 0; k < 2; ++k) dst[m][k] = *(const PG8_LAS bf16x8*)(lds + PG8_SA(b, h) + aoff + m * 2048 + k * 1024); } while (0)
#define PG8_LDB(dst, b, h) do { _Pragma("unroll") for (int n = 0; n < 2; ++n) _Pragma("unroll") for (int k = 0; k < 2; ++k) dst[n][k] = *(const PG8_LAS bf16x8*)(lds + PG8_SB(b, h) + boff + n * 2048 + k * 1024); } while (0)
#define PG8_MMA(ai, bj, At, Bt) do { __builtin_amdgcn_s_setprio(1); _Pragma("unroll") for (int m = 0; m < 4; ++m) _Pragma("unroll") for (int n = 0; n < 2; ++n) _Pragma("unroll") for (int k = 0; k < 2; ++k) \
        acc[ai][bj][m][n] = __builtin_amdgcn_mfma_f32_16x16x32_bf16(Bt[n][k], At[m][k], acc[ai][bj][m][n], 0, 0, 0); __builtin_amdgcn_s_setprio(0); } while (0)
#define PG8_WAIT_V(n) asm volatile("s_waitcnt vmcnt(" #n ")" ::: "memory")
#define PG8_WAIT_L(n) asm volatile("s_waitcnt lgkmcnt(" #n ")" ::: "memory")
#define PG8_BAR __builtin_amdgcn_s_barrier()
#define PG8_SCHED __builtin_amdgcn_sched_barrier(0)
    Unit cur, nxt; int ui = 0;
    if (!S.next(0, cur)) return;
    f32x4 acc[2][2][4][2];
#pragma unroll
    for (int a = 0; a < 2; ++a)
#pragma unroll
        for (int b = 0; b < 2; ++b)
#pragma unroll
            for (int m = 0; m < 4; ++m)
#pragma unroll
                for (int n = 0; n < 2; ++n) acc[a][b][m][n] = (f32x4){0.f, 0.f, 0.f, 0.f};
    bf16x8 At[4][2], B0[2][2], B1[2][2];
    const char* cA = (const char*)g.A + (size_t)cur.pm * tstepA; const char* cB = (const char*)g.Bt + (size_t)cur.pn * tstep;
    S.a_ready(cur);
    if constexpr (SP2) {
        PG8_STAGE(PG8_SB(0, 0), cB, voffB); PG8_STAGE(PG8_SB(0, 1), cB + hstep, voffB); PG8_STAGE(PG8_SA(0, 0), cA, voffA); PG8_STAGE(PG8_SA(0, 1), cA + hstepA, voffA);
        if (wr == 1) PG8_BAR;
        PG8_WAIT_V(2); PG8_BAR;
        PG8_STAGE(PG8_SB(1, 0), cB + kstep, voffB); PG8_STAGE(PG8_SA(1, 0), cA + kstep, voffA); PG8_STAGE(PG8_SB(1, 1), cB + hstep + kstep, voffB);
        PG8_WAIT_V(6); PG8_BAR;
    } else {
        PG8_STAGE(PG8_SB(0, 0), cB, voffB); PG8_STAGE(PG8_SA(0, 0), cA, voffA); PG8_STAGE(PG8_SB(0, 1), cB + hstep, voffB); PG8_STAGE(PG8_SA(0, 1), cA + hstepA, voffA);
        if (wr == 1) PG8_BAR;
        PG8_WAIT_V(4); PG8_BAR;
        PG8_STAGE(PG8_SB(1, 0), cB + kstep, voffB); PG8_STAGE(PG8_SA(1, 0), cA + kstep, voffA); PG8_STAGE(PG8_SB(1, 1), cB + hstep + kstep, voffB);
        PG8_WAIT_V(6); PG8_BAR;
    }
    for (;;) {
        const bool has_next = S.next(ui + 1, nxt);
        const char* nA = has_next ? (const char*)g.A + (size_t)nxt.pm * tstepA : cA; const char* nB = has_next ? (const char*)g.Bt + (size_t)nxt.pn * tstep : cB;
        _Pragma("unroll 1") for (int t = 0; t < nt; t += 2) {
            const bool last = (t == nt - 2);
            const char* a1 = cA + (size_t)(t + 1) * kstep;
            const char* a2 = last ? nA : cA + (size_t)(t + 2) * kstep; const char* b2 = last ? nB : cB + (size_t)(t + 2) * kstep;
            const char* a3 = a2 + kstep; const char* b3 = b2 + kstep;
            if (last && has_next) S.a_ready(nxt);
            if constexpr (SP2) {
            PG8_LDB(B0, 0, 0); PG8_LDB(B1, 0, 1); PG8_SCHED; PG8_LDA(At, 0, 0); PG8_STAGE(PG8_SA(1, 1), a1 + hstepA, voffA);
            PG8_WAIT_V(8); PG8_WAIT_L(0); PG8_BAR; PG8_MMA(0, 0, At, B0); PG8_MMA(0, 1, At, B1); PG8_BAR; PG8_SCHED;
            PG8_LDA(At, 0, 1); PG8_STAGE(PG8_SB(0, 0), b2, voffB); PG8_STAGE(PG8_SB(0, 1), b2 + hstep, voffB); PG8_STAGE(PG8_SA(0, 0), a2, voffA);
            PG8_WAIT_V(8); PG8_WAIT_L(0); PG8_BAR; PG8_MMA(1, 0, At, B0); PG8_MMA(1, 1, At, B1); PG8_BAR; PG8_SCHED;
            PG8_LDB(B0, 1, 0); PG8_LDB(B1, 1, 1); PG8_SCHED; PG8_LDA(At, 1, 0); PG8_STAGE(PG8_SA(0, 1), a2 + hstepA, voffA);
            PG8_WAIT_V(8); PG8_WAIT_L(0); PG8_BAR; PG8_MMA(0, 0, At, B0); PG8_MMA(0, 1, At, B1); PG8_BAR; PG8_SCHED;
            PG8_LDA(At, 1, 1); PG8_STAGE(PG8_SB(1, 0), b3, voffB); PG8_STAGE(PG8_SB(1, 1), b3 + hstep, voffB); PG8_STAGE(PG8_SA(1, 0), a3, voffA);
            PG8_WAIT_V(8); PG8_WAIT_L(0); PG8_BAR; PG8_MMA(1, 0, At, B0); PG8_MMA(1, 1, At, B1); PG8_BAR; PG8_SCHED;
            } else {
            PG8_LDB(B0, 0, 0); PG8_SCHED; PG8_LDA(At, 0, 0); PG8_STAGE(PG8_SA(1, 1), a1 + hstepA, voffA);
            PG8_WAIT_L(8); PG8_BAR; PG8_WAIT_L(0); PG8_MMA(0, 0, At, B0); PG8_BAR; PG8_SCHED;
            PG8_LDB(B1, 0, 1); PG8_STAGE(PG8_SB(0, 0), b2, voffB);
            PG8_BAR; PG8_WAIT_L(0); PG8_MMA(0, 1, At, B1); PG8_BAR;
            PG8_LDA(At, 0, 1); PG8_STAGE(PG8_SA(0, 0), a2, voffA);
            PG8_BAR; PG8_WAIT_L(0); PG8_MMA(1, 0, At, B0); PG8_BAR; PG8_SCHED;
            PG8_STAGE(PG8_SB(0, 1), b2 + hstep, voffB);
            PG8_WAIT_V(6); PG8_BAR; PG8_MMA(1, 1, At, B1); PG8_BAR;
            PG8_LDB(B0, 1, 0); PG8_SCHED; PG8_LDA(At, 1, 0); PG8_STAGE(PG8_SA(0, 1), a2 + hstepA, voffA);
            PG8_WAIT_L(8); PG8_BAR; PG8_WAIT_L(0); PG8_MMA(0, 0, At, B0); PG8_BAR; PG8_SCHED;
            PG8_LDB(B1, 1, 1); PG8_STAGE(PG8_SB(1, 0), b3, voffB);
            PG8_BAR; PG8_WAIT_L(0); PG8_MMA(0, 1, At, B1); PG8_BAR;
            PG8_LDA(At, 1, 1); PG8_STAGE(PG8_SA(1, 0), a3, voffA);
            PG8_BAR; PG8_WAIT_L(0); PG8_MMA(1, 0, At, B0); PG8_BAR; PG8_SCHED;
            PG8_STAGE(PG8_SB(1, 1), b3 + hstep, voffB);
            PG8_WAIT_V(6); PG8_BAR; PG8_MMA(1, 1, At, B1); PG8_BAR;
            }
        }
        if constexpr (ALIGN_EPI) { if (wr == 0) PG8_BAR; }
        if constexpr (!Epi::AFTER_DRAIN) { E(acc, cur, wr, wc, fr, fq); S.done(cur); }
        if (!has_next) break;
#pragma unroll
        for (int a = 0; a < 2; ++a)
#pragma unroll
            for (int b = 0; b < 2; ++b)
#pragma unroll
                for (int m = 0; m < 4; ++m)
#pragma unroll
                    for (int n = 0; n < 2; ++n) acc[a][b][m][n] = (f32x4){0.f, 0.f, 0.f, 0.f};
        cur = nxt; cA = nA; cB = nB; ++ui;
        if constexpr (ALIGN_EPI) { if (wr == 1) PG8_BAR; }
    }
    PG8_WAIT_V(0);
    if constexpr (!ALIGN_EPI) { if (wr == 0) PG8_BAR; }
    PG8_BAR;
    if constexpr (Epi::AFTER_DRAIN) { E.fused(acc, cur, wr, wc, fr, fq, lds, wid, lane); S.done(cur); }
#undef PG8_SA
#undef PG8_SB
#undef PG8_STAGE
#undef PG8_LDA
#undef PG8_LDB
#undef PG8_MMA
#undef PG8_WAIT_V
#undef PG8_WAIT_L
#undef PG8_BAR
#undef PG8_SCHED
}
}
#define GAS __attribute__((address_space(1)))
#define LAS __attribute__((address_space(3)))
typedef unsigned short bf16;
typedef unsigned v4u __attribute__((ext_vector_type(4)));
typedef float f32x4 __attribute__((ext_vector_type(4)));
typedef short bf16x8 __attribute__((ext_vector_type(8)));
typedef GAS unsigned gu32;
typedef GAS unsigned long long gu64;
#define RLX_AGENT __ATOMIC_RELAXED, __HIP_MEMORY_SCOPE_AGENT
#define LDS_WAIT() asm volatile("s_waitcnt lgkmcnt(0)" ::: "memory")
#define VM_WAIT() asm volatile("s_waitcnt vmcnt(0)" ::: "memory")
__device__ __forceinline__ unsigned long long rt() { return __builtin_amdgcn_s_memrealtime(); }
__device__ __forceinline__ unsigned f2bf(float f) { unsigned u = __builtin_bit_cast(unsigned, f); return (u + 0x7fffu + ((u >> 16) & 1u)) >> 16; }
__device__ __forceinline__ unsigned pk2(float lo, float hi) { return f2bf(lo) | (f2bf(hi) << 16); }

#define XB_TMO      128
#define XB_XCNT(j)  (256  + 64 * (j))
#define XB_XSUB(j)  (1280 + 64 * (j))
#define XB_XGEN(j)  (2304 + 64 * (j))
#define XB_TOP      3328
#define XB_TOPGEN   3392
#define XCD_BAR_WORDS 3456
#define XB_SPIN_CAP (1u << 18)

__device__ __forceinline__ unsigned xb_ld(unsigned* p)              { return __hip_atomic_load(p, __ATOMIC_RELAXED, __HIP_MEMORY_SCOPE_AGENT); }
__device__ __forceinline__ unsigned xb_add(unsigned* p, unsigned v) { return __hip_atomic_fetch_add(p, v, __ATOMIC_RELAXED, __HIP_MEMORY_SCOPE_AGENT); }
__device__ __forceinline__ unsigned xb_xcc_id() { return (unsigned)__builtin_amdgcn_s_getreg((3 << 11) | 20) & 0xFu; }
#define XB_SPIN(cond, bar) do { unsigned _sp = 0; while (cond) { __builtin_amdgcn_s_sleep(1); \
    if ((++_sp & 255u) == 0u) { if (xb_ld(&(bar)[XB_TMO])) break; if (_sp > XB_SPIN_CAP) { atomicAdd(&(bar)[XB_TMO], 1u); break; } } } } while (0)

struct XcdBarrier {
    unsigned* bar; unsigned x;
    volatile LAS unsigned* st;
};

__device__ __forceinline__ XcdBarrier xcd_barrier_post(unsigned* bar, volatile LAS unsigned* st) {
    XcdBarrier b; b.bar = bar; b.x = xb_xcc_id(); b.st = st;
    if (threadIdx.x == 0) (void)xb_add(&bar[XB_XCNT(b.x)], 1u);
    return b;
}
__device__ __forceinline__ void xcd_barrier_complete(unsigned* bar, unsigned x, unsigned& nloc, unsigned& nx) {
    const unsigned G = gridDim.x * gridDim.y * gridDim.z;
    unsigned sum, cnt, mine, sp = 0u;
    for (;;) {
        sum = 0u; cnt = 0u; mine = 0u;
#pragma unroll
        for (unsigned j = 0; j < 16; ++j) { const unsigned c = xb_ld(&bar[XB_XCNT(j)]); sum += c; cnt += (c > 0u) ? 1u : 0u; mine = (j == x) ? c : mine; }
        if (sum == G) break;
        __builtin_amdgcn_s_sleep(1);
        if ((++sp & 255u) == 0u) { if (xb_ld(&bar[XB_TMO])) break; if (sp > XB_SPIN_CAP) { atomicAdd(&bar[XB_TMO], 1u); break; } }
    }
    nloc = mine > 0u ? mine : 1u; nx = cnt > 0u ? cnt : 1u;
}

__device__ __forceinline__ void xcd_barrier(const XcdBarrier& b) {
    asm volatile("s_waitcnt vmcnt(0)" ::: "memory");
    __syncthreads();
    if (threadIdx.x == 0) {
        unsigned* bar = b.bar;
        __builtin_amdgcn_s_waitcnt(0);
        unsigned nloc = b.st[0], nx = b.st[1];
        if (nloc == 0u) { xcd_barrier_complete(bar, b.x, nloc, nx); b.st[0] = nloc; b.st[1] = nx; }
        const unsigned old = xb_add(&bar[XB_XSUB(b.x)], 1u);
        const unsigned gen = old / nloc;
        if (old + 1u == (gen + 1u) * nloc) {
            __builtin_amdgcn_fence(__ATOMIC_RELEASE, "agent");
            asm volatile("s_waitcnt vmcnt(0)" ::: "memory");
            const unsigned og = xb_add(&bar[XB_TOP], 1u);
            const unsigned tg = og / nx;
            if (og + 1u == (tg + 1u) * nx) xb_add(&bar[XB_TOPGEN], 1u);
            else XB_SPIN(xb_ld(&bar[XB_TOPGEN]) == tg, bar);
            __builtin_amdgcn_fence(__ATOMIC_ACQUIRE, "agent");
            xb_add(&bar[XB_XGEN(b.x)], 1u);
            asm volatile("s_waitcnt vmcnt(0)" ::: "memory");
        } else {
            XB_SPIN(xb_ld(&bar[XB_XGEN(b.x)]) == gen, bar);
            __builtin_amdgcn_fence(__ATOMIC_ACQUIRE, "agent");
            asm volatile("s_waitcnt vmcnt(0)" ::: "memory");
        }
    }
    __syncthreads();
}

__device__ __forceinline__ void xcd_local_barrier(unsigned* lw, unsigned* bar, unsigned x, unsigned nloc) {
    asm volatile("s_waitcnt vmcnt(0)" ::: "memory");
    __syncthreads();
    if (threadIdx.x == 0) {
        __builtin_amdgcn_s_waitcnt(0);
        const unsigned old = xb_add(&lw[64 * x], 1u), gen = old / nloc;
        if (old + 1u == (gen + 1u) * nloc) xb_add(&lw[1024 + 64 * x], 1u);
        else XB_SPIN(xb_ld(&lw[1024 + 64 * x]) == gen, bar);
        __builtin_amdgcn_fence(__ATOMIC_ACQUIRE, "agent");
        asm volatile("s_waitcnt vmcnt(0)" ::: "memory");
    }
    __syncthreads();
}

constexpr int NWAVES = 8;
constexpr int BATCH = 8, SEQ = 4096, DM = 2048, DEPTH = 4, HD = 128, NHS = 8, NHD = 8, INW = 6144, DFF = 5632, PLI = 256;
constexpr int PJP = INW + 128;
constexpr int M = BATCH * SEQ;
constexpr float RMS_EPS = 1e-6f;
constexpr float QK_SCALE = 0.08838834764831845f;
constexpr float LOG2E = 1.4426950408889634f;
#ifndef MK_N_LAUNCHES
#define MK_N_LAUNCHES 1
#endif
constexpr int PH_PER_LAYER = 10, N_PHASES = 1 + DEPTH * PH_PER_LAYER;
constexpr size_t MiB = 1u << 20;
constexpr size_t WS_CTL = 0, CTL_ZERO_BYTES = 1 * MiB;
constexpr size_t WS_W = 1 * MiB, W_LAYER = 107 * MiB;
constexpr size_t WO_IN = 0, WO_OUT = 24 * MiB, WO_GU = 32 * MiB, WO_DN = 76 * MiB, WO_PG = 98 * MiB, WO_PP = 106 * MiB;
constexpr size_t WS_H = 432 * MiB;
constexpr size_t WS_PROJ = 560 * MiB;
constexpr size_t WS_O = 952 * MiB;
constexpr size_t WS_Y = 1080 * MiB;
constexpr size_t WS_P16 = 1208 * MiB;
constexpr size_t WS_DLP = WS_Y;
constexpr size_t WS_XH = 1224 * MiB;
constexpr size_t WS_LSE = 1352 * MiB;
constexpr size_t WS_END = 1354 * MiB;
static_assert(WS_PROJ + (size_t)M * PJP * 2 <= WS_O && WS_PROJ + (size_t)M * DFF * 2 <= WS_O, "PROJ / ACT overlay fits below O");
constexpr int CW_TMO = 0, CW_CODE = 1, CW_BAR = 4096, CW_GRP = 8192  , CW_X0 = 10240  , CW_BAD = 10304  ;
constexpr int RING_OFF = 0, RING_BYTES = 131072;
constexpr int LDSCTL_OFF = RING_BYTES, MISC_OFF = LDSCTL_OFF + 320;
constexpr int TAB_OFF = RING_BYTES + 1024;
constexpr int VOTE_OFF = TAB_OFF + 20480;
constexpr int LDS_BYTES = 155648;

struct Frame {
    LAS unsigned char* lds;
    volatile LAS unsigned* MISC;
    gu32* ctl;
    int wave;
    int vcu, G;
};
struct Args { const float* in[15]; float* out; unsigned char* ws; int ph_lo, ph_hi, li, pad; };

__device__ __forceinline__ float xor_lane(float v, int mask, int lane) { return __int_as_float(__builtin_amdgcn_ds_bpermute((lane ^ mask) << 2, __float_as_int(v))); }
__device__ __forceinline__ float wave_sum(float v, int lane) {
#pragma unroll
    for (int o = 1; o < 64; o <<= 1) v += xor_lane(v, o, lane);
    return v;
}
__device__ __forceinline__ int opaque_v(int x) { asm volatile("" : "+v"(x)); return x; }
__device__ __forceinline__ int lane_now() { return opaque_v((int)__builtin_amdgcn_mbcnt_hi(~0u, __builtin_amdgcn_mbcnt_lo(~0u, 0u))); }
__device__ __forceinline__ float bf_lo(unsigned u) { return __uint_as_float(u << 16); }
__device__ __forceinline__ float bf_hi(unsigned u) { return __uint_as_float(u & 0xffff0000u); }

__device__ __forceinline__ void p0_transpose_item(const float* W, int K, int N, bf16* WT, int k0, int n0, int dst_row0, LAS float* scr, int lane) {
#pragma unroll 8
    for (int i = 0; i < 32; ++i) { const int kk = 2 * i + (lane >> 5); scr[kk * 33 + (lane & 31)] = W[(size_t)(k0 + kk) * N + n0 + (lane & 31)]; }
    LDS_WAIT(); asm volatile("" ::: "memory");
    const int c = lane & 7;
#pragma unroll
    for (int j = 0; j < 4; ++j) { const int n = (lane >> 3) + 8 * j; const LAS float* s = scr + (8 * c) * 33 + n;
        v4u o; o.x = pk2(s[0 * 33], s[1 * 33]); o.y = pk2(s[2 * 33], s[3 * 33]); o.z = pk2(s[4 * 33], s[5 * 33]); o.w = pk2(s[6 * 33], s[7 * 33]);
        *(GAS v4u*)(WT + (size_t)(dst_row0 + n) * K + k0 + 8 * c) = o; }
    LDS_WAIT(); asm volatile("" ::: "memory");
}
__device__ __forceinline__ void convert_weights(Frame& F, const Args& a) {
    LAS float* scr = (LAS float*)(F.lds + RING_OFF + F.wave * 16384);
    const int gw = F.vcu * NWAVES + F.wave, NGW = F.G * NWAVES, lane = lane_now();
    constexpr int I_IN = (DM / 64) * (INW / 32), I_OUT = (DM / 64) * (DM / 32), I_GU = (DM / 64) * (2 * DFF / 32), I_DN = (DFF / 64) * (DM / 32), I_PG = I_OUT, I_PP = (PLI / 64) * (DM / 32);
    constexpr int I_LAYER = I_IN + I_OUT + I_GU + I_DN + I_PG + I_PP;
    for (int it = gw; it < DEPTH * I_LAYER; it += NGW) {
        const int L = it / I_LAYER; int r = it % I_LAYER;
        unsigned char* wl = a.ws + WS_W + (size_t)L * W_LAYER;
        const float* W; int K, N; bf16* WT; bool gu = false;
        if (r < I_IN) { W = a.in[3] + (size_t)L * DM * INW; K = DM; N = INW; WT = (bf16*)(wl + WO_IN); }
        else if ((r -= I_IN) < I_OUT) { W = a.in[5] + (size_t)L * DM * DM; K = DM; N = DM; WT = (bf16*)(wl + WO_OUT); }
        else if ((r -= I_OUT) < I_GU) { W = a.in[9] + (size_t)L * DM * 2 * DFF; K = DM; N = 2 * DFF; WT = (bf16*)(wl + WO_GU); gu = true; }
        else if ((r -= I_GU) < I_DN) { W = a.in[10] + (size_t)L * DFF * DM; K = DFF; N = DM; WT = (bf16*)(wl + WO_DN); }
        else if ((r -= I_DN) < I_PG) { W = a.in[13] + (size_t)L * DM * DM; K = DM; N = DM; WT = (bf16*)(wl + WO_PG); }
        else { r -= I_PG; W = a.in[14] + (size_t)L * PLI * DM; K = PLI; N = DM; WT = (bf16*)(wl + WO_PP); }
        const int nblk = N / 32, kb = r / nblk, nb = r % nblk, k0 = 64 * kb, n0 = 32 * nb;
        int d0 = n0;
        if (gu) { d0 = (n0 < DFF) ? 256 * (n0 / 128) + (n0 % 128) : 256 * ((n0 - DFF) / 128) + 128 + ((n0 - DFF) % 128); }
        p0_transpose_item(W, K, N, WT, k0, n0, d0, scr, lane);
    }
}
struct Row32 { float v[4][8]; };
__device__ __forceinline__ void load_f32_row(const float* p, int lane, Row32& r) {
#pragma unroll
    for (int j = 0; j < 4; ++j) { const f32x4 a = *(const GAS f32x4*)(p + 512 * j + 8 * lane), b = *(const GAS f32x4*)(p + 512 * j + 8 * lane + 4);
        r.v[j][0] = a[0]; r.v[j][1] = a[1]; r.v[j][2] = a[2]; r.v[j][3] = a[3]; r.v[j][4] = b[0]; r.v[j][5] = b[1]; r.v[j][6] = b[2]; r.v[j][7] = b[3]; }
}
__device__ __forceinline__ void store_f32_row(float* p, int lane, const Row32& r) {
#pragma unroll
    for (int j = 0; j < 4; ++j) { f32x4 a, b; a[0] = r.v[j][0]; a[1] = r.v[j][1]; a[2] = r.v[j][2]; a[3] = r.v[j][3]; b[0] = r.v[j][4]; b[1] = r.v[j][5]; b[2] = r.v[j][6]; b[3] = r.v[j][7];
        *(GAS f32x4*)(p + 512 * j + 8 * lane) = a; *(GAS f32x4*)(p + 512 * j + 8 * lane + 4) = b; }
}
__device__ __forceinline__ void load_bf16_row(const bf16* p, int lane, Row32& r) {
#pragma unroll
    for (int j = 0; j < 4; ++j) { const v4u a = *(const GAS v4u*)(p + 512 * j + 8 * lane);
        r.v[j][0] = bf_lo(a.x); r.v[j][1] = bf_hi(a.x); r.v[j][2] = bf_lo(a.y); r.v[j][3] = bf_hi(a.y); r.v[j][4] = bf_lo(a.z); r.v[j][5] = bf_hi(a.z); r.v[j][6] = bf_lo(a.w); r.v[j][7] = bf_hi(a.w); }
}
__device__ __forceinline__ float row_sumsq(const Row32& r, int lane) {
    float s = 0.f;
#pragma unroll
    for (int j = 0; j < 4; ++j)
#pragma unroll
        for (int e = 0; e < 8; ++e) s += r.v[j][e] * r.v[j][e];
    return wave_sum(s, lane);
}
__device__ __forceinline__ void store_norm_bf16(bf16* p, int lane, const Row32& x, float rstd, const Row32& g) {
#pragma unroll
    for (int j = 0; j < 4; ++j) { v4u o;
        o.x = pk2(x.v[j][0] * rstd * g.v[j][0], x.v[j][1] * rstd * g.v[j][1]); o.y = pk2(x.v[j][2] * rstd * g.v[j][2], x.v[j][3] * rstd * g.v[j][3]);
        o.z = pk2(x.v[j][4] * rstd * g.v[j][4], x.v[j][5] * rstd * g.v[j][5]); o.w = pk2(x.v[j][6] * rstd * g.v[j][6], x.v[j][7] * rstd * g.v[j][7]);
        *(GAS v4u*)(p + 512 * j + 8 * lane) = o; }
}
__device__ __forceinline__ void load_h16_row(const unsigned short* p, int lane, Row32& r) {
#pragma unroll
    for (int j = 0; j < 4; ++j) { const v4u a = *(const GAS v4u*)(p + 512 * j + 8 * lane);
        r.v[j][0] = pg8::h_lo(a.x); r.v[j][1] = pg8::h_hi(a.x); r.v[j][2] = pg8::h_lo(a.y); r.v[j][3] = pg8::h_hi(a.y); r.v[j][4] = pg8::h_lo(a.z); r.v[j][5] = pg8::h_hi(a.z); r.v[j][6] = pg8::h_lo(a.w); r.v[j][7] = pg8::h_hi(a.w); }
}
__device__ __forceinline__ void store_h16_row(unsigned short* p, int lane, const Row32& r) {
#pragma unroll
    for (int j = 0; j < 4; ++j) { v4u o; o.x = pg8::pkh2(r.v[j][0], r.v[j][1]); o.y = pg8::pkh2(r.v[j][2], r.v[j][3]); o.z = pg8::pkh2(r.v[j][4], r.v[j][5]); o.w = pg8::pkh2(r.v[j][6], r.v[j][7]);
        *(GAS v4u*)(p + 512 * j + 8 * lane) = o; }
}
__device__ __forceinline__ void norm_only_phase(Frame& F, const float* xs32, const unsigned short* xsh, const float* gain, bf16* H) {
    const int lane = lane_now(), m0 = (F.vcu >> 5) * SEQ + (F.vcu & 31) * NWAVES + F.wave;
    Row32 g; load_f32_row(gain, lane, g);
    for (int m = m0; m < m0 + SEQ; m += 32 * NWAVES) {
        Row32 x; if (xs32) load_f32_row(xs32 + (size_t)m * DM, lane, x); else load_h16_row(xsh + (size_t)m * DM, lane, x);
        const float rstd = rsqrtf(row_sumsq(x, lane) * (1.f / DM) + RMS_EPS);
        store_norm_bf16(H + (size_t)m * DM, lane, x, rstd, g);
    }
}
__device__ __forceinline__ void resid_norm_phase(Frame& F, const float* xs32, const unsigned short* xsh, unsigned short* xdh, const bf16* Y, const float* gain1, const float* gain2, bf16* H, const float* prow, bf16* P16) {
    const int lane = lane_now(), m0 = (F.vcu >> 5) * SEQ + (F.vcu & 31) * NWAVES + F.wave;
    Row32 g1, g2; load_f32_row(gain1, lane, g1); load_f32_row(gain2, lane, g2);
    for (int m = m0; m < m0 + SEQ; m += 32 * NWAVES) {
        Row32 y, x; load_bf16_row(Y + (size_t)m * DM, lane, y);
        if (xs32) load_f32_row(xs32 + (size_t)m * DM, lane, x); else load_h16_row(xsh + (size_t)m * DM, lane, x);
        const float r1 = rsqrtf(row_sumsq(y, lane) * (1.f / DM) + RMS_EPS);
#pragma unroll
        for (int j = 0; j < 4; ++j)
#pragma unroll
            for (int e = 0; e < 8; ++e) x.v[j][e] += y.v[j][e] * r1 * g1.v[j][e];
        store_h16_row(xdh + (size_t)m * DM, lane, x);
        const float r2 = rsqrtf(row_sumsq(x, lane) * (1.f / DM) + RMS_EPS);
        store_norm_bf16(H + (size_t)m * DM, lane, x, r2, g2);
        if (prow) { const f32x4 pv = *(const GAS f32x4*)(prow + (size_t)m * PLI + 4 * lane);
            unsigned long long w = (unsigned long long)pk2(pv[0], pv[1]) | ((unsigned long long)pk2(pv[2], pv[3]) << 32);
            *(GAS unsigned long long*)(P16 + (size_t)m * PLI + 4 * lane) = w; }
    }
}
__device__ __forceinline__ int t5_bucket(int dist) {
    if (dist < 16) return dist;
    const float v = logf((float)dist * (1.f / 16.f)) / 4.852030263919617f * 16.f;
    const int large = 16 + (int)v; return large < 31 ? large : 31;
}
namespace fa {
typedef __bf16 bf16x8_t __attribute__((ext_vector_type(8)));
typedef float f32x8 __attribute__((ext_vector_type(8)));
typedef short s16x8 __attribute__((ext_vector_type(8)));
typedef short s16x4 __attribute__((ext_vector_type(4)));
typedef float f32x16 __attribute__((ext_vector_type(16)));
constexpr float SC2 = QK_SCALE * LOG2E;
constexpr float NEG_BIG = -1e30f;
constexpr float SB_EXIT = -150.f;
constexpr float DEFER = 8.f;
constexpr int TAB_PAD = 32, TAB_STRIDE = 200;

__device__ __forceinline__ unsigned off_b(unsigned row, unsigned ch) { return 256u * row + 16u * (ch ^ (((row & 3u) << 2) | ((row >> 2) & 3u))); }
#define FA_WAIT_V(n) asm volatile("s_waitcnt vmcnt(" #n ")" ::: "memory")
__device__ __forceinline__ void load_q(s16x8 (&qf)[8], const bf16* qrow, int lane) {
#pragma unroll
    for (int s = 0; s < 8; ++s) qf[s] = *(const GAS s16x8*)(qrow + 16 * s + 8 * (lane >> 5));
}
__device__ __forceinline__ unsigned long long pack4(float a, float b, float c, float d) { return (unsigned long long)pk2(a, b) | ((unsigned long long)pk2(c, d) << 32); }
__device__ __forceinline__ void swap32(unsigned& a, unsigned& b) { const auto r = __builtin_amdgcn_permlane32_swap(a, b, false, false); a = r[0]; b = r[1]; }
typedef unsigned u32x4s __attribute__((ext_vector_type(4)));
__device__ __forceinline__ void store_pair16(bf16* dst, unsigned long long Y, unsigned long long X) {
    unsigned y0 = (unsigned)Y, y1 = (unsigned)(Y >> 32), x0 = (unsigned)X, x1 = (unsigned)(X >> 32);
    swap32(y0, x0); swap32(y1, x1);
    u32x4s w; w.x = y0; w.y = y1; w.z = x0; w.w = x1; *(GAS u32x4s*)dst = w;
}
__device__ __forceinline__ void unswap_pair16(u32x4s w, unsigned long long& Y, unsigned long long& X) {
    unsigned l0 = w.x, l1 = w.y, l2 = w.z, l3 = w.w;
    swap32(l0, l2); swap32(l1, l3);
    Y = (unsigned long long)l0 | ((unsigned long long)l1 << 32); X = (unsigned long long)l2 | ((unsigned long long)l3 << 32);
}
__device__ __forceinline__ void headnorm_store(const f32x16 (&o)[4], bf16* orow, const float* g, int lane_) {
    const int lane = opaque_v(lane_), hh = lane >> 5;
    float ss = 0.f;
#pragma unroll
    for (int db = 0; db < 4; ++db)
#pragma unroll
        for (int i = 0; i < 16; ++i) ss += o[db][i] * o[db][i];
    ss += xor_lane(ss, 32, lane);
    const float rstd = rsqrtf(ss * (1.f / HD) + RMS_EPS);
#pragma unroll
    for (int db = 0; db < 4; ++db)
#pragma unroll
        for (int g2 = 0; g2 < 2; ++g2) { unsigned long long P[2];
#pragma unroll
            for (int q = 0; q < 2; ++q) { const int gq = 2 * g2 + q, d = 32 * db + 8 * gq + 4 * hh; const f32x4 gv = *(const GAS f32x4*)(g + d);
                P[q] = pack4(o[db][4 * gq] * rstd * gv[0], o[db][4 * gq + 1] * rstd * gv[1], o[db][4 * gq + 2] * rstd * gv[2], o[db][4 * gq + 3] * rstd * gv[3]); }
            store_pair16(orow + 32 * db + 16 * g2 + 8 * hh, P[0], P[1]); }
}
template <bool DIAG> __device__ __forceinline__ f32x16 sb_weights(const f32x16& x, float& carry, int qrel, int hh, int lane) {
    float lk[16], zz[16];
#pragma unroll
    for (int i = 0; i < 16; ++i) { const float z2 = x[i] * SC2, e = __builtin_amdgcn_exp2f(-fabsf(z2)), sp = fmaxf(z2, 0.f) + __builtin_amdgcn_logf(1.f + e);
        lk[i] = -sp; zz[i] = z2 - sp;
        if (DIAG) { const bool valid = ((i & 3) + 8 * (i >> 2)) < qrel; lk[i] = valid ? lk[i] : 0.f; zz[i] = valid ? zz[i] : NEG_BIG; } }
    float T[4], To[4];
#pragma unroll
    for (int g = 0; g < 4; ++g) { T[g] = (lk[4 * g] + lk[4 * g + 1]) + (lk[4 * g + 2] + lk[4 * g + 3]); To[g] = xor_lane(T[g], 32, lane); }
    const float pr0 = T[0] + To[0], pr1 = T[1] + To[1], pr2 = T[2] + To[2], pr3 = T[3] + To[3];
    float U[4]; U[3] = 0.f; U[2] = pr3; U[1] = pr3 + pr2; U[0] = U[1] + pr1;
    f32x16 p;
#pragma unroll
    for (int g = 0; g < 4; ++g) { float later = carry + U[g] + (hh == 0 ? To[g] : 0.f);
        p[4 * g + 3] = __builtin_amdgcn_exp2f(zz[4 * g + 3] + later); later += lk[4 * g + 3];
        p[4 * g + 2] = __builtin_amdgcn_exp2f(zz[4 * g + 2] + later); later += lk[4 * g + 2];
        p[4 * g + 1] = __builtin_amdgcn_exp2f(zz[4 * g + 1] + later); later += lk[4 * g + 1];
        p[4 * g + 0] = __builtin_amdgcn_exp2f(zz[4 * g + 0] + later); }
    carry += U[0] + pr0;
    return p;
}
__device__ __forceinline__ void dl_store_partial(const f32x16 (&o)[4], float m, float l, bf16* DLP, float* LSE, int grp, int b, int hd, int P0, int dil, int lane) {
    const int r = lane & 31, hh = lane >> 5; const size_t row = (size_t)b * SEQ + P0 + r * dil;
    bf16* dp = DLP + row * 2048 + (size_t)(grp - 1) * 1024 + hd * HD + 8 * hh;
    const float inv = 1.f / l;
#pragma unroll
    for (int db = 0; db < 4; ++db)
#pragma unroll
        for (int g2 = 0; g2 < 2; ++g2)
            store_pair16(dp + 32 * db + 16 * g2, pack4(o[db][8 * g2] * inv, o[db][8 * g2 + 1] * inv, o[db][8 * g2 + 2] * inv, o[db][8 * g2 + 3] * inv),
                         pack4(o[db][8 * g2 + 4] * inv, o[db][8 * g2 + 5] * inv, o[db][8 * g2 + 6] * inv, o[db][8 * g2 + 7] * inv));
    if (hh == 0) *(GAS float*)(LSE + (size_t)(grp - 1) * M * 8 + row * 8 + hd) = m + __builtin_amdgcn_logf(l);
}
__device__ __forceinline__ void dl_combine_store(f32x16 (&o)[4], float m, float l, const bf16* DLP, const float* LSE, bf16* O, const float* ghead, int b, int hd, int P0, int lane) {
    const int r = lane & 31, hh = lane >> 5; const size_t row = (size_t)b * SEQ + P0 + r;
    const float lse0 = m + __builtin_amdgcn_logf(l);
    const float lse1 = *(const GAS float*)(LSE + row * 8 + hd), lse2 = *(const GAS float*)(LSE + (size_t)M * 8 + row * 8 + hd);
    const float mx = fmaxf(lse0, fmaxf(lse1, lse2));
    const float e0 = __builtin_amdgcn_exp2f(lse0 - mx), w1 = __builtin_amdgcn_exp2f(lse1 - mx), w2 = __builtin_amdgcn_exp2f(lse2 - mx);
    const float invW = 1.f / (e0 + w1 + w2), w0 = e0 / l;
    const bf16* p1 = DLP + row * 2048 + hd * HD + 8 * hh; const bf16* p2 = p1 + 1024;
    u32x4s la[4][2], lc[4][2];
#pragma unroll
    for (int db = 0; db < 4; ++db)
#pragma unroll
        for (int g2 = 0; g2 < 2; ++g2) { la[db][g2] = *(const GAS u32x4s*)(p1 + 32 * db + 16 * g2); lc[db][g2] = *(const GAS u32x4s*)(p2 + 32 * db + 16 * g2); }
    unsigned long long a[4][4], c[4][4];
#pragma unroll
    for (int db = 0; db < 4; ++db)
#pragma unroll
        for (int g2 = 0; g2 < 2; ++g2) { unswap_pair16(la[db][g2], a[db][2 * g2], a[db][2 * g2 + 1]); unswap_pair16(lc[db][g2], c[db][2 * g2], c[db][2 * g2 + 1]); }
#pragma unroll
    for (int db = 0; db < 4; ++db)
#pragma unroll
        for (int gq = 0; gq < 4; ++gq) { const unsigned a0 = (unsigned)a[db][gq], a1 = (unsigned)(a[db][gq] >> 32), c0 = (unsigned)c[db][gq], c1 = (unsigned)(c[db][gq] >> 32);
            o[db][4 * gq]     = (o[db][4 * gq]     * w0 + bf_lo(a0) * w1 + bf_lo(c0) * w2) * invW;
            o[db][4 * gq + 1] = (o[db][4 * gq + 1] * w0 + bf_hi(a0) * w1 + bf_hi(c0) * w2) * invW;
            o[db][4 * gq + 2] = (o[db][4 * gq + 2] * w0 + bf_lo(a1) * w1 + bf_lo(c1) * w2) * invW;
            o[db][4 * gq + 3] = (o[db][4 * gq + 3] * w0 + bf_hi(a1) * w1 + bf_hi(c1) * w2) * invW; }
    headnorm_store(o, O + row * DM + 1024 + hd * HD, ghead + 1024 + hd * HD, lane);
}
}
namespace fb {
using fa::s16x8; using fa::s16x4; using fa::f32x16; using fa::f32x8; using fa::bf16x8_t; using fa::off_b; using fa::SC2; using fa::NEG_BIG; using fa::SB_EXIT; using fa::DEFER; using fa::TAB_PAD; using fa::TAB_STRIDE;
struct TAddr { unsigned kR, kX, vR, vY, vQ, dma[2]; };
__device__ __forceinline__ void team_addr(TAddr& A, LAS unsigned char* ring, int i, int dil, int lane) {
    const unsigned kb = (unsigned)(size_t)ring;
    const unsigned r = lane & 31, h = lane >> 5, blk = (lane >> 4) & 1, q = (lane & 15) >> 2, pp = lane & 3;
    A.kR = kb + 256u * r; A.kX = h ^ (((r & 3u) << 2) | ((r >> 2) & 3u));
    A.vR = kb + 8192u + 256u * (4 * h + q) + 8u * (pp & 1); A.vY = (2 * blk + (pp >> 1)) ^ h; A.vQ = q;
#pragma unroll
    for (int qq = 0; qq < 2; ++qq) { const unsigned p = 2 * i + qq, row = 4 * p + (lane >> 4), ch = (lane & 15) ^ ((((lane >> 4) & 3) << 2) | (p & 3));
        A.dma[qq] = (row * (unsigned)dil * PJP + ch * 8) * 2u; }
}
__device__ __forceinline__ void team_issue(LAS unsigned char* slot, int i, const char* kb0, const TAddr& A) {
#pragma unroll
    for (int qq = 0; qq < 2; ++qq) {
        __builtin_amdgcn_global_load_lds((const unsigned*)(kb0 + A.dma[qq]), (LAS unsigned*)(slot + 1024 * (2 * i + qq)), 16, 0, 0);
        __builtin_amdgcn_global_load_lds((const unsigned*)(kb0 + 2048 + A.dma[qq]), (LAS unsigned*)(slot + 8192 + 1024 * (2 * i + qq)), 16, 0, 0); }
}
__device__ __forceinline__ f32x16 qk_slot(const TAddr& A, unsigned so, const s16x8 (&qf)[8]) {
    s16x8 k0, k1, k2, k3, k4, k5, k6, k7;
    const unsigned R = A.kR + so, X = A.kX;
    asm volatile("ds_read_b128 %0, %8\n\tds_read_b128 %1, %9\n\tds_read_b128 %2, %10\n\tds_read_b128 %3, %11\n\tds_read_b128 %4, %12\n\tds_read_b128 %5, %13\n\tds_read_b128 %6, %14\n\tds_read_b128 %7, %15\n\ts_waitcnt lgkmcnt(0)"
                 : "=&v"(k0), "=&v"(k1), "=&v"(k2), "=&v"(k3), "=&v"(k4), "=&v"(k5), "=&v"(k6), "=&v"(k7)
                 : "v"(R + ((0u ^ X) << 4)), "v"(R + ((2u ^ X) << 4)), "v"(R + ((4u ^ X) << 4)), "v"(R + ((6u ^ X) << 4)), "v"(R + ((8u ^ X) << 4)), "v"(R + ((10u ^ X) << 4)), "v"(R + ((12u ^ X) << 4)), "v"(R + ((14u ^ X) << 4)) : "memory");
    f32x16 x;
#pragma unroll
    for (int e = 0; e < 16; ++e) x[e] = 0.f;
    x = __builtin_amdgcn_mfma_f32_32x32x16_bf16(k0, qf[0], x, 0, 0, 0); x = __builtin_amdgcn_mfma_f32_32x32x16_bf16(k1, qf[1], x, 0, 0, 0);
    x = __builtin_amdgcn_mfma_f32_32x32x16_bf16(k2, qf[2], x, 0, 0, 0); x = __builtin_amdgcn_mfma_f32_32x32x16_bf16(k3, qf[3], x, 0, 0, 0);
    x = __builtin_amdgcn_mfma_f32_32x32x16_bf16(k4, qf[4], x, 0, 0, 0); x = __builtin_amdgcn_mfma_f32_32x32x16_bf16(k5, qf[5], x, 0, 0, 0);
    x = __builtin_amdgcn_mfma_f32_32x32x16_bf16(k6, qf[6], x, 0, 0, 0); x = __builtin_amdgcn_mfma_f32_32x32x16_bf16(k7, qf[7], x, 0, 0, 0);
    return x;
}
__device__ __forceinline__ void pv_slot(f32x16 (&o)[4], const TAddr& A, unsigned so, const f32x16& p) {
    s16x8 pf[2];
#pragma unroll
    for (int s = 0; s < 2; ++s) { f32x8 t;
#pragma unroll
        for (int j = 0; j < 8; ++j) t[j] = p[8 * s + j];
        pf[s] = __builtin_bit_cast(s16x8, __builtin_convertvector(t, bf16x8_t)); }
    const unsigned R0 = A.vR + so + ((A.vY ^ 0u) << 4), R1 = A.vR + so + 2048u + ((A.vY ^ 2u) << 4), Q = A.vQ;
    s16x4 v0, v1, v2, v3, v4, v5, v6, v7, v8, v9, v10, v11, v12, v13, v14, v15;
    asm volatile("ds_read_b64_tr_b16 %0, %16\n\tds_read_b64_tr_b16 %1, %17\n\tds_read_b64_tr_b16 %2, %16 offset:4096\n\tds_read_b64_tr_b16 %3, %17 offset:4096\n\t"
                 "ds_read_b64_tr_b16 %4, %18\n\tds_read_b64_tr_b16 %5, %19\n\tds_read_b64_tr_b16 %6, %18 offset:4096\n\tds_read_b64_tr_b16 %7, %19 offset:4096\n\t"
                 "ds_read_b64_tr_b16 %8, %20\n\tds_read_b64_tr_b16 %9, %21\n\tds_read_b64_tr_b16 %10, %20 offset:4096\n\tds_read_b64_tr_b16 %11, %21 offset:4096\n\t"
                 "ds_read_b64_tr_b16 %12, %22\n\tds_read_b64_tr_b16 %13, %23\n\tds_read_b64_tr_b16 %14, %22 offset:4096\n\tds_read_b64_tr_b16 %15, %23 offset:4096\n\ts_waitcnt lgkmcnt(0)"
                 : "=&v"(v0), "=&v"(v1), "=&v"(v2), "=&v"(v3), "=&v"(v4), "=&v"(v5), "=&v"(v6), "=&v"(v7), "=&v"(v8), "=&v"(v9), "=&v"(v10), "=&v"(v11), "=&v"(v12), "=&v"(v13), "=&v"(v14), "=&v"(v15)
                 : "v"(R0 + ((0u ^ Q) << 6)), "v"(R1 + ((0u ^ Q) << 6)), "v"(R0 + ((1u ^ Q) << 6)), "v"(R1 + ((1u ^ Q) << 6)), "v"(R0 + ((2u ^ Q) << 6)), "v"(R1 + ((2u ^ Q) << 6)), "v"(R0 + ((3u ^ Q) << 6)), "v"(R1 + ((3u ^ Q) << 6)) : "memory");
#define FB_VF(a, b) __builtin_shufflevector(a, b, 0, 1, 2, 3, 4, 5, 6, 7)
    o[0] = __builtin_amdgcn_mfma_f32_32x32x16_bf16(FB_VF(v0, v1), pf[0], o[0], 0, 0, 0);   o[1] = __builtin_amdgcn_mfma_f32_32x32x16_bf16(FB_VF(v4, v5), pf[0], o[1], 0, 0, 0);
    o[2] = __builtin_amdgcn_mfma_f32_32x32x16_bf16(FB_VF(v8, v9), pf[0], o[2], 0, 0, 0);   o[3] = __builtin_amdgcn_mfma_f32_32x32x16_bf16(FB_VF(v12, v13), pf[0], o[3], 0, 0, 0);
    o[0] = __builtin_amdgcn_mfma_f32_32x32x16_bf16(FB_VF(v2, v3), pf[1], o[0], 0, 0, 0);   o[1] = __builtin_amdgcn_mfma_f32_32x32x16_bf16(FB_VF(v6, v7), pf[1], o[1], 0, 0, 0);
    o[2] = __builtin_amdgcn_mfma_f32_32x32x16_bf16(FB_VF(v10, v11), pf[1], o[2], 0, 0, 0); o[3] = __builtin_amdgcn_mfma_f32_32x32x16_bf16(FB_VF(v14, v15), pf[1], o[3], 0, 0, 0);
#undef FB_VF
}
__device__ __forceinline__ f32x16 dl_probs(const f32x16& x, f32x16 (&o)[4], float& m, float& l, const LAS float* tab, int KB, bool edge, int kmin, int r, int hh) {
    const int lane = r + 32 * hh;
    const LAS float* tp = tab + (TAB_PAD + 128 + r - 32 * KB - 4 * hh - 27);
    const int klo = kmin - 32 * KB - 4 * hh;
    float tb[16];
#pragma unroll
    for (int e = 0; e < 16; ++e) tb[e] = tp[27 - ((e & 3) + 8 * (e >> 2))];
    f32x16 s;
#pragma unroll
    for (int e = 0; e < 16; ++e) s[e] = x[e] * SC2 + tb[e];
    if (KB == 4) {
#pragma unroll
        for (int e = 0; e < 16; ++e) s[e] = (((e & 3) + 8 * (e >> 2)) + 4 * hh <= r) ? s[e] : NEG_BIG; }
    if (KB == 0) {
#pragma unroll
        for (int e = 0; e < 16; ++e) s[e] = (((e & 3) + 8 * (e >> 2)) + 4 * hh >= r) ? s[e] : NEG_BIG; }
    if (edge) {
#pragma unroll
        for (int e = 0; e < 16; ++e) s[e] = (((e & 3) + 8 * (e >> 2)) >= klo) ? s[e] : NEG_BIG; }
    float bm = NEG_BIG;
#pragma unroll
    for (int e = 0; e < 16; ++e) bm = fmaxf(bm, s[e]);
    bm = fmaxf(bm, xor_lane(bm, 32, lane));
    if (__any(bm > m + DEFER)) {
        const float mn = fmaxf(m, bm), alpha = __builtin_amdgcn_exp2f(m - mn);
        m = mn; l *= alpha;
#pragma unroll
        for (int db = 0; db < 4; ++db)
#pragma unroll
            for (int e = 0; e < 16; ++e) o[db][e] *= alpha;
    }
    f32x16 p; float ls = 0.f;
#pragma unroll
    for (int e = 0; e < 16; ++e) { p[e] = __builtin_amdgcn_exp2f(s[e] - m); ls += p[e]; }
    l += ls;
    return p;
}
#define FB_BAR() do { asm volatile("" ::: "memory"); __builtin_amdgcn_s_barrier(); asm volatile("" ::: "memory"); } while (0)
__device__ __forceinline__ void dl_chunk(Frame& F, LAS unsigned char* ring, const LAS float* tab, const bf16* PROJ, bf16* DLP, float* LSE, bf16* O, const float* ghead, int b, int hd, int C0, int dil, int grp, int lane) {
    const int i = F.wave & 3, r = lane & 31, hh = lane >> 5;
    const bf16* base = PROJ + (size_t)b * SEQ * PJP;
    TAddr A; team_addr(A, ring, i, dil, lane);
    const int P0 = C0 + 32 * i * dil;
    s16x8 qf[8]; fa::load_q(qf, base + (size_t)(P0 + r * dil) * PJP + 3072 + hd * HD, lane);
    f32x16 o[4];
#pragma unroll
    for (int db = 0; db < 4; ++db)
#pragma unroll
        for (int e = 0; e < 16; ++e) o[db][e] = 0.f;
    float m = NEG_BIG, l = 0.f;
    const int kmin = 128 - P0 / dil; const bool edge = kmin > 0;
    const char* kc = (const char*)(base + (size_t)C0 * PJP + 4096 + hd * HD);
    const long BLK = 32L * dil * PJP * 2;
#define FB_KB0(J) (kc + ((C0 + (32 * (J) - 97) * dil) < 0 ? 0L : (long)((J) - 4) * BLK))
    team_issue(ring + 16384 * (7 & 3), i, FB_KB0(7), A);
    team_issue(ring + 16384 * (6 & 3), i, FB_KB0(6), A);
    team_issue(ring + 16384 * (5 & 3), i, FB_KB0(5), A);
#pragma unroll 1
    for (int J = 7; J >= 0; --J) {
        if (J >= 2) FA_WAIT_V(8);
        else if (J == 1) FA_WAIT_V(4);
        else FA_WAIT_V(0);
        FB_BAR();
        if (J >= 3) team_issue(ring + 16384 * ((J - 3) & 3), i, FB_KB0(J - 3), A);
        const int KB = J - i;
        if (KB >= 0 && KB <= 4 && 32 * KB + 31 >= kmin) {
            const unsigned so = 16384u * (unsigned)(J & 3);
            const f32x16 x = qk_slot(A, so, qf);
            const f32x16 p = dl_probs(x, o, m, l, tab, KB, edge, kmin, r, hh);
            pv_slot(o, A, so, p);
        }
    }
#undef FB_KB0
    l += xor_lane(l, 32, lane);
    if (grp != 0) fa::dl_store_partial(o, m, l, DLP, LSE, grp, b, hd, P0, dil, opaque_v(lane));
    else fa::dl_combine_store(o, m, l, DLP, LSE, O, ghead, b, hd, P0, opaque_v(lane));
}
__device__ __forceinline__ void sb_chunk(Frame& F, LAS unsigned char* ring, volatile LAS unsigned* votes, const bf16* PROJ, bf16* O, const float* ghead, int b, int h, int C0, int lane) {
    const int i = F.wave & 3, r = lane & 31, hh = lane >> 5;
    const bf16* base = PROJ + (size_t)b * SEQ * PJP;
    TAddr A; team_addr(A, ring, i, 1, lane);
    const int t0 = C0 + 32 * i;
    s16x8 qf[8]; fa::load_q(qf, base + (size_t)(t0 + r) * PJP + h * HD, lane);
    f32x16 o[4];
#pragma unroll
    for (int db = 0; db < 4; ++db)
#pragma unroll
        for (int e = 0; e < 16; ++e) o[db][e] = 0.f;
    float carry = 0.f; bool done = false;
    const char* kc = (const char*)(base + (size_t)C0 * PJP + 1024 + h * HD);
    constexpr long BLK = 32L * PJP * 2;
    const int Jmin = -(C0 >> 5);
#define FB_KB0(J) (kc + (long)((J) < Jmin ? Jmin : (J)) * BLK)
    team_issue(ring + 16384 * (3 & 3), i, FB_KB0(3), A);
    team_issue(ring + 16384 * (2 & 3), i, FB_KB0(2), A);
    team_issue(ring + 16384 * (1 & 3), i, FB_KB0(1), A);
    int par = 0;
#pragma unroll 1
    for (int J = 3; ; --J) {
        FA_WAIT_V(8);
        if (lane == 0) votes[8 * par + F.wave] = (done || J < Jmin) ? 1u : 0u;
        asm volatile("s_waitcnt lgkmcnt(0)" ::: "memory");
        FB_BAR();
        unsigned nd = 0;
#pragma unroll
        for (int k = 0; k < 8; ++k) nd += votes[8 * par + k];
        par ^= 1;
        if (nd == 8u) break;
        team_issue(ring + 16384 * ((J - 3) & 3), i, FB_KB0(J - 3), A);
        if (!done && J <= i && J >= Jmin) {
            const unsigned so = 16384u * (unsigned)(J & 3);
            const f32x16 x = qk_slot(A, so, qf);
            f32x16 p;
            if (J == i) p = fa::sb_weights<true>(x, carry, r - 4 * hh, hh, lane); else p = fa::sb_weights<false>(x, carry, 0, hh, lane);
            pv_slot(o, A, so, p);
            done = __all(carry < SB_EXIT);
        }
    }
#undef FB_KB0
    fa::headnorm_store(o, O + ((size_t)b * SEQ + t0 + r) * DM + h * HD, ghead + h * HD, lane);
    FA_WAIT_V(16);
}
}
__device__ __forceinline__ void dl_tables_all(LAS float* tab, const float* relb) {
    for (int e = (int)threadIdx.x; e < NHD * 3 * fa::TAB_STRIDE; e += NWAVES * 64) { const int h = e / (3 * fa::TAB_STRIDE), e2 = e % (3 * fa::TAB_STRIDE), grp = e2 / fa::TAB_STRIDE, rel = e2 % fa::TAB_STRIDE - fa::TAB_PAD, dil = grp == 0 ? 1 : (grp == 1 ? 4 : 16);
        tab[e] = (rel >= 0 && rel <= 128) ? relb[t5_bucket(rel * dil) * NHD + h] * LOG2E : 0.f; }
}
__device__ __forceinline__ void attn_phase_a(Frame& F, const bf16* PROJ, bf16* DLP, float* LSE) {
    const int lane = lane_now(), w = F.wave;
    LAS unsigned char* ring = F.lds + RING_OFF + (w >> 2) * 65536;
    const LAS float* tab = (const LAS float*)(F.lds + TAB_OFF);
    const int b = F.vcu >> 5, T = (F.vcu & 31) * 2 + (w >> 2);
#pragma unroll 1
    for (int h = 0; h < NHD; ++h) {
        const LAS float* th = tab + h * 3 * fa::TAB_STRIDE;
        if (T < 32) fb::dl_chunk(F, ring, th + 2 * fa::TAB_STRIDE, PROJ, DLP, LSE, nullptr, nullptr, b, h, (128 * (T & 1)) * 16 + (T >> 1), 16, 2, opaque_v(lane));
        else        fb::dl_chunk(F, ring, th + 1 * fa::TAB_STRIDE, PROJ, DLP, LSE, nullptr, nullptr, b, h, (128 * ((T - 32) & 7)) * 4 + ((T - 32) >> 3), 4, 1, opaque_v(lane));
    }
    FA_WAIT_V(0);
}
__device__ __forceinline__ void attn_phase_b(Frame& F, const bf16* PROJ, bf16* O, bf16* DLP, float* LSE, const float* ghead) {
    const int lane = lane_now(), w = F.wave;
    LAS unsigned char* ring = F.lds + RING_OFF + (w >> 2) * 65536;
    const LAS float* tab = (const LAS float*)(F.lds + TAB_OFF);
    volatile LAS unsigned* votes = (volatile LAS unsigned*)(F.lds + VOTE_OFF);
    const int b = F.vcu >> 5, j = F.vcu & 31, c = (j & 15) * 2 + (w >> 2);
#pragma unroll 1
    for (int h = 0; h < 8; ++h) {
        const bool dl_role = ((j >> 4) ^ (h & 1)) == 0;
        if (dl_role) fb::dl_chunk(F, ring, tab + h * 3 * fa::TAB_STRIDE, PROJ, DLP, LSE, O, ghead, b, h, 128 * c, 1, 0, opaque_v(lane));
        else fb::sb_chunk(F, ring, votes, PROJ, O, ghead, b, h, 128 * c, opaque_v(lane));
    }
    FA_WAIT_V(0);
}
__global__ void __launch_bounds__(NWAVES * 64, 2) mega_fwd(Args args) {
    extern __shared__ __attribute__((aligned(16))) unsigned char lds[];
    Frame F;
    F.lds = (LAS unsigned char*)lds;
    F.MISC = (volatile LAS unsigned*)(F.lds + MISC_OFF);
    F.wave = __builtin_amdgcn_readfirstlane((int)threadIdx.x >> 6);
    F.G = gridDim.x; { const int bx = blockIdx.x; F.vcu = (F.G % 8 == 0) ? (bx % 8) * (F.G / 8) + bx / 8 : bx; }
    unsigned char* ws = args.ws;
    F.ctl = (gu32*)(ws + WS_CTL);
    for (int u = (int)threadIdx.x; u < (LDS_BYTES - LDSCTL_OFF) / 4; u += NWAVES * 64) ((LAS unsigned*)(F.lds + LDSCTL_OFF))[u] = 0u;
    __syncthreads();
    dl_tables_all((LAS float*)(F.lds + TAB_OFF), args.in[7]);
    __syncthreads();
    const int lo = args.ph_lo, hi = args.ph_hi;
    const bool use_bar = (hi - lo) > 1;
    XcdBarrier bar; bar.bar = (unsigned*)(F.ctl + CW_BAR); bar.x = 0; bar.st = nullptr;
    if (use_bar) bar = xcd_barrier_post((unsigned*)(F.ctl + CW_BAR), F.MISC + 8);
#define IN(k) (lo <= (k) && (k) < hi)
    bool xloc = false; unsigned xnloc = 1;
#define SEAM(k) do { if (IN(k) && IN((k) + 1)) { if (xloc) xcd_local_barrier((unsigned*)(F.ctl + CW_GRP), bar.bar, bar.x, xnloc); else xcd_barrier(bar); } } while (0)
    bf16* const H = (bf16*)(ws + WS_H); bf16* const PROJ = (bf16*)(ws + WS_PROJ); bf16* const ACT = (bf16*)(ws + WS_PROJ);
    bf16* const OB = (bf16*)(ws + WS_O); bf16* const Y = (bf16*)(ws + WS_Y); bf16* const P16 = (bf16*)(ws + WS_P16);
    float* const out = args.out;
    unsigned short* const XH = (unsigned short*)(ws + WS_XH);

    if (IN(0)) { convert_weights(F, args); norm_only_phase(F, args.in[0], nullptr, args.in[2], H); }
    if (use_bar && blockIdx.x < 8 && threadIdx.x == 0) __hip_atomic_store((unsigned*)(F.ctl + CW_X0 + blockIdx.x), bar.x + 1u, __ATOMIC_RELAXED, __HIP_MEMORY_SCOPE_AGENT);
    SEAM(0);
    if (use_bar && F.G == 256 && threadIdx.x == 0) {
        const unsigned ref = __hip_atomic_load((unsigned*)(F.ctl + CW_X0 + (blockIdx.x & 7)), __ATOMIC_RELAXED, __HIP_MEMORY_SCOPE_AGENT);
        if (ref != bar.x + 1u || F.MISC[8] != 32u) (void)__hip_atomic_fetch_or((unsigned*)(F.ctl + CW_BAD), 1u, __ATOMIC_RELAXED, __HIP_MEMORY_SCOPE_AGENT);
    }
    for (int L = 0; L < DEPTH; ++L) {
        const int p0 = 1 + L * PH_PER_LAYER;
        unsigned char* wl = ws + WS_W + (size_t)L * W_LAYER;
        const float* x32 = (L == 0) ? args.in[0] : nullptr;
        if (IN(p0 + 0)) { pg8::Gemm g{H, (const bf16*)(wl + WO_IN), M, INW, DM, DM}; pg8::StaticOrder S; S.init(M, INW, F.G, (int)blockIdx.x);
            pg8::EpiStore E{PROJ, PJP}; pg8::gemm_phase<pg8::EpiStore, pg8::StaticOrder, true, true>(F.lds + RING_OFF, g, S, E); }
        SEAM(p0 + 0);
        if (L == 0 && use_bar && F.G == 256 && lo == 0) {
            xloc = __hip_atomic_load((unsigned*)(F.ctl + CW_BAD), __ATOMIC_RELAXED, __HIP_MEMORY_SCOPE_AGENT) == 0u; xnloc = 32u; }
        if (IN(p0 + 1)) {
            attn_phase_a(F, PROJ, (bf16*)(ws + WS_DLP), (float*)(ws + WS_LSE));
        }
        SEAM(p0 + 1);
        if (IN(p0 + 2)) {
            attn_phase_b(F, PROJ, OB, (bf16*)(ws + WS_DLP), (float*)(ws + WS_LSE), args.in[4] + (size_t)L * DM);
        }
        SEAM(p0 + 2);
        if (IN(p0 + 3)) { pg8::Gemm g{OB, (const bf16*)(wl + WO_OUT), M, DM, DM, DM}; pg8::StaticOrder S; S.init(M, DM, F.G, (int)blockIdx.x);
            pg8::EpiStore E{Y, DM}; pg8::gemm_phase<pg8::EpiStore, pg8::StaticOrder, true, true>(F.lds + RING_OFF, g, S, E); }
        SEAM(p0 + 3);
        if (IN(p0 + 4)) { resid_norm_phase(F, x32, XH, XH, Y, args.in[6] + (size_t)L * DM, args.in[8] + (size_t)L * DM, H, nullptr, nullptr); }
        SEAM(p0 + 4);
        if (IN(p0 + 5)) { pg8::Gemm g{H, (const bf16*)(wl + WO_GU), M, 2 * DFF, DM, DM}; pg8::StaticOrder S; S.init(M, 2 * DFF, F.G, (int)blockIdx.x);
            pg8::EpiSwiGLU E{ACT, PJP}; pg8::gemm_phase<pg8::EpiSwiGLU, pg8::StaticOrder, true, true>(F.lds + RING_OFF, g, S, E); }
        SEAM(p0 + 5);
        if (IN(p0 + 6)) { pg8::Gemm g{ACT, (const bf16*)(wl + WO_DN), M, DM, DFF, PJP};   pg8::StaticOrder S; S.init(M, DM, F.G, (int)blockIdx.x);
            pg8::EpiStore E{Y, DM}; pg8::gemm_phase<pg8::EpiStore, pg8::StaticOrder, true, true>(F.lds + RING_OFF, g, S, E); }
        SEAM(p0 + 6);
        if (IN(p0 + 7)) { resid_norm_phase(F, nullptr, XH, XH, Y, args.in[11] + (size_t)L * DM, args.in[12] + (size_t)L * DM, H, args.in[1] + (size_t)L * M * PLI, P16); }
        SEAM(p0 + 7);
        if (IN(p0 + 8)) {
            { pg8::Gemm g{P16, (const bf16*)(wl + WO_PP), M, DM, PLI, PLI}; pg8::StaticOrder S; S.init(M, DM, F.G, (int)blockIdx.x);
              pg8::EpiStore E{Y, DM}; pg8::gemm_phase<pg8::EpiStore, pg8::StaticOrder, true, true>(F.lds + RING_OFF, g, S, E); }
            __syncthreads();
            { pg8::Gemm g{H, (const bf16*)(wl + WO_PG), M, DM, DM, DM}; pg8::StaticOrder S; S.init(M, DM, F.G, (int)blockIdx.x);
              pg8::EpiPli E{XH, XH, (L + 1 == DEPTH) ? out : nullptr, Y, DM};     pg8::gemm_phase<pg8::EpiPli, pg8::StaticOrder, true, true>(F.lds + RING_OFF, g, S, E); }
        }
        SEAM(p0 + 8);
        if (IN(p0 + 9) && L + 1 < DEPTH) { norm_only_phase(F, nullptr, XH, args.in[2] + (size_t)(L + 1) * DM, H); }
        SEAM(p0 + 9);
    }
#undef IN
#undef SEAM
}

extern "C" void kernel_launch(void* const* d_in, const int* in_sizes, int n_in, void* d_out, int out_size, void* d_ws, size_t ws_size, hipStream_t stream) {
    static int grid = 0;
    if (grid == 0) {
        if (n_in != 15 || in_sizes[0] != M * DM || out_size != M * DM || ws_size < WS_END) { fprintf(stderr, "kernel_launch: unexpected shapes or workspace (n_in %d, in0 %d, out %d, ws %zu < %zu); nothing launched\n", n_in, n_in > 0 ? in_sizes[0] : -1, out_size, ws_size, (size_t)WS_END); grid = -1; return; }
        int dev = 0, cus = 0, per_cu = 0;
        if (hipGetDevice(&dev) != hipSuccess || hipDeviceGetAttribute(&cus, hipDeviceAttributeMultiprocessorCount, dev) != hipSuccess) { fprintf(stderr, "kernel_launch: device query failed\n"); grid = -1; return; }
        if (hipFuncSetAttribute((const void*)mega_fwd, hipFuncAttributeMaxDynamicSharedMemorySize, LDS_BYTES) != hipSuccess) { fprintf(stderr, "kernel_launch: hipFuncSetAttribute failed\n"); grid = -1; return; }
        if (hipOccupancyMaxActiveBlocksPerMultiprocessor(&per_cu, (const void*)mega_fwd, NWAVES * 64, LDS_BYTES) != hipSuccess || per_cu < 1)
            fprintf(stderr, "kernel_launch: note: occupancy query reports %d workgroups per CU\n", per_cu);
        (void)hipGetLastError();
        if (cus != 256) { fprintf(stderr, "kernel_launch: built for a 256-CU device (the token-mixing phases deal work per XCD group of 32 workgroups); found %d CUs; nothing launched\n", cus); grid = -1; return; }
        grid = cus;
    }
    if (grid < 0) return;
    if (hipMemsetAsync((char*)d_ws + WS_CTL, 0, CTL_ZERO_BYTES, stream) != hipSuccess) { fprintf(stderr, "kernel_launch: memset failed\n"); return; }
    Args a{};
    for (int i = 0; i < 15; ++i) a.in[i] = (const float*)d_in[i];
    a.out = (float*)d_out; a.ws = (unsigned char*)d_ws;
#if MK_N_LAUNCHES == 1
    a.ph_lo = 0; a.ph_hi = N_PHASES; a.li = 0;
    hipLaunchKernelGGL(mega_fwd, dim3(grid), dim3(NWAVES * 64), LDS_BYTES, stream, a);
#else
    for (int p = 0; p < N_PHASES - 1; ++p) { a.ph_lo = p; a.ph_hi = p + 1; a.li = p;
        hipLaunchKernelGGL(mega_fwd, dim3(grid), dim3(NWAVES * 64), LDS_BYTES, stream, a); }
#endif
    const hipError_t le = hipPeekAtLastError();
    if (le != hipSuccess) fprintf(stderr, "kernel_launch: launch failed: %s\n", hipGetErrorName(le));
}
```
